# Optimizing an MI355X kernel written in HIP

```python
import math
import jax, jax.numpy as jnp
from jax import lax
import numpy as np

D_MODEL = 1024
BATCH = 16
SEQ = 2048
DEPTH = 1

CHUNK = 64
Q_BLOCK = 128
SB_HEADS = 16
SB_HEAD_DIM = 64
SB_WIDTH = SB_HEADS * SB_HEAD_DIM
CV_WIDTH = D_MODEL
CV_KERNEL = 31
LN_EPS = 1e-5
DEEPNORM_ALPHA = (2.0 * DEPTH) ** 0.25
DEEPNORM_BETA = (8.0 * DEPTH) ** -0.25
SPLIT_SIZES = (SB_WIDTH, SB_WIDTH, SB_WIDTH, SB_WIDTH, CV_WIDTH, CV_WIDTH, CV_WIDTH, D_MODEL, D_MODEL)
IN_WIDTH = sum(SPLIT_SIZES)
SPLIT_POINTS = tuple(int(i) for i in np.cumsum(SPLIT_SIZES)[:-1])

kernel_name = "stickbreak_conformer_gated_hybrid"


def _layer_norm(x, g, b):
    xf = x.astype(jnp.float32)
    mu = jnp.mean(xf, axis=-1, keepdims=True)
    var = jnp.mean(jnp.square(xf - mu), axis=-1, keepdims=True)
    y = (xf - mu) * lax.rsqrt(var + LN_EPS) * g.astype(jnp.float32) + b.astype(jnp.float32)
    return y.astype(x.dtype)


def _stick_breaking_attention(q, k, v):
    seq = q.shape[1]
    scale = 1.0 / math.sqrt(q.shape[-1])
    qf = q.astype(jnp.float32) * scale
    kf = k.astype(jnp.float32)
    vf = v.astype(jnp.float32)
    outs = []
    for start in range(0, seq, Q_BLOCK):
        end = start + Q_BLOCK
        logits = jnp.einsum('bqhd,bkhd->bhqk', qf[:, start:end], kf[:, :end])
        t_idx = start + jnp.arange(Q_BLOCK)[:, None]
        s_idx = jnp.arange(end)[None, :]
        mask = s_idx < t_idx
        log_not_beta = jnp.where(mask, jax.nn.log_sigmoid(-logits), 0.0)
        later = lax.cumsum(log_not_beta, axis=3, reverse=True) - log_not_beta
        weights = jnp.where(mask, jnp.exp(jax.nn.log_sigmoid(logits) + later), 0.0)
        outs.append(jnp.einsum('bhqk,bkhd->bqhd', weights, vf[:, :end]))
    return jnp.concatenate(outs, axis=1).astype(q.dtype)


def _causal_depthwise_conv(u, w, b):
    kw = w.shape[0]
    y = lax.conv_general_dilated(
        u, w[:, None, :].astype(u.dtype), window_strides=(1,), padding=[(kw - 1, 0)],
        dimension_numbers=('NWC', 'WIO', 'NWC'), feature_group_count=u.shape[-1])
    return y + b.astype(u.dtype)


def _hybrid_layer(x, w_in, w_sb_proj, conv_w, conv_b, conv_ln_g, conv_ln_b,
                  w_cv_proj, w_out, ln_g, ln_b):
    bsz, seq, _ = x.shape
    h = x @ w_in
    q, k, v, z_sb, c_val, c_gate, z_cv, g_sb, g_cv = jnp.split(h, SPLIT_POINTS, axis=-1)

    to_heads = lambda t: t.reshape(bsz, seq, SB_HEADS, SB_HEAD_DIM)
    o_sb = _stick_breaking_attention(to_heads(q), to_heads(k), to_heads(v)).reshape(bsz, seq, SB_WIDTH)
    y_sb = (o_sb * jax.nn.silu(z_sb)) @ w_sb_proj

    u = c_val * jax.nn.sigmoid(c_gate)
    u = _causal_depthwise_conv(u, conv_w, conv_b)
    u = jax.nn.silu(_layer_norm(u, conv_ln_g, conv_ln_b))
    y_cv = (u * jax.nn.silu(z_cv)) @ w_cv_proj

    merged = jax.nn.sigmoid(g_sb) * y_sb + jax.nn.sigmoid(g_cv) * y_cv
    return _layer_norm(DEEPNORM_ALPHA * x + merged @ w_out, ln_g, ln_b)


def setup_inputs(seed: int = 0) -> dict:
    key = jax.random.key(seed)
    ks = jax.random.split(key, 14)
    n = lambda kk, shape: jax.random.normal(kk, shape, dtype=jnp.float32)
    x = n(ks[0], (BATCH, SEQ, D_MODEL))
    ln_in_g = 1.0 + 0.02 * n(ks[1], (D_MODEL,))
    ln_in_b = 0.02 * n(ks[2], (D_MODEL,))
    w_in = n(ks[3], (DEPTH, D_MODEL, IN_WIDTH)) * D_MODEL ** -0.5
    w_sb_proj = n(ks[4], (DEPTH, SB_WIDTH, D_MODEL)) * (SB_WIDTH ** -0.5) * DEEPNORM_BETA
    conv_w = n(ks[5], (DEPTH, CV_KERNEL, CV_WIDTH)) * CV_KERNEL ** -0.5
    conv_b = 0.02 * n(ks[6], (DEPTH, CV_WIDTH))
    conv_ln_g = 1.0 + 0.02 * n(ks[7], (DEPTH, CV_WIDTH))
    conv_ln_b = 0.02 * n(ks[8], (DEPTH, CV_WIDTH))
    w_cv_proj = n(ks[9], (DEPTH, CV_WIDTH, D_MODEL)) * (CV_WIDTH ** -0.5) * DEEPNORM_BETA
    w_out = n(ks[10], (DEPTH, D_MODEL, D_MODEL)) * (D_MODEL ** -0.5) * DEEPNORM_BETA
    ln_post_g = 1.0 + 0.02 * n(ks[11], (DEPTH, D_MODEL))
    ln_post_b = 0.02 * n(ks[12], (DEPTH, D_MODEL))
    return {"x": x, "ln_in_g": ln_in_g, "ln_in_b": ln_in_b, "w_in": w_in,
            "w_sb_proj": w_sb_proj, "conv_w": conv_w, "conv_b": conv_b,
            "conv_ln_g": conv_ln_g, "conv_ln_b": conv_ln_b, "w_cv_proj": w_cv_proj,
            "w_out": w_out, "ln_post_g": ln_post_g, "ln_post_b": ln_post_b}


def reference(x, ln_in_g, ln_in_b, w_in, w_sb_proj, conv_w, conv_b, conv_ln_g, conv_ln_b,
              w_cv_proj, w_out, ln_post_g, ln_post_b):
    h = _layer_norm(x, ln_in_g, ln_in_b)
    for l in range(DEPTH):
        h = _hybrid_layer(h, w_in[l], w_sb_proj[l], conv_w[l], conv_b[l], conv_ln_g[l],
                          conv_ln_b[l], w_cv_proj[l], w_out[l], ln_post_g[l], ln_post_b[l])
    return h
```

```cpp
#include <hip/hip_runtime.h>
#include <hip/hip_cooperative_groups.h>
#include <cstdio>
#include <cstdint>
namespace cg = cooperative_groups;

namespace pg8 {
#define PG8_LAS __attribute__((address_space(3)))
typedef unsigned short bf16_t;
typedef short bf16x8 __attribute__((ext_vector_type(8)));
typedef float f32x4 __attribute__((ext_vector_type(4)));
typedef unsigned u32x4 __attribute__((ext_vector_type(4)));
constexpr int BM = 256, BK = 64, HALF = 128, HTB = HALF * BK * 2  , STAGE_BYTES = 8 * HTB, NXCD = 8, WGM = 8;

__host__ __device__ __forceinline__ int lds_byte(int r, int c) { const int st = (r >> 4) * 2 + (c >> 5), rr = r & 15, cc = c & 31, ob = rr * 64 + cc * 2; return st * 1024 + (ob ^ (((ob >> 9) & 1) << 5)); }
__host__ __device__ __forceinline__ void stage_rc(int b, int& R, int& C) { const int st = b / 1024, sb = b % 1024, swz = sb ^ (((sb >> 9) & 1) << 5); R = (st >> 1) * 16 + swz / 64; C = (st & 1) * 32 + (swz % 64) / 2; }
__host__ __device__ __forceinline__ int perm32(int rho) { const int n = rho >> 4, i = rho & 15; return 8 * (i >> 2) + 4 * n + (i & 3); }

struct Unit { int pm, pn, kt0, nkt, mode; };
struct Gemm { const bf16_t* A; const bf16_t* Bt; int M, N, K; };

struct StaticOrder {
    int nM, nN, nwg, G, c, nkt;
    __host__ __device__ void init(int M, int N, int G_, int c_, int K = 1024) { nM = M / BM; nN = N / BM; nwg = nM * nN; G = G_; c = c_; nkt = K / BK; }
    __host__ __device__ bool next(int i, Unit& u) const {
        const long L = (long)i * G + c; if (L >= nwg) return false;
        int wgid = (int)L; { const int q = nwg / NXCD, r = nwg % NXCD, xcd = wgid % NXCD, off = wgid / NXCD; wgid = (xcd < r ? xcd * (q + 1) : r * (q + 1) + (xcd - r) * q) + off; }
        const int nig = WGM * nN, gid = wgid / nig, fm = gid * WGM, gsz = (nM - fm) < WGM ? (nM - fm) : WGM;
        u.pm = fm + ((wgid % nig) % gsz); u.pn = (wgid % nig) / gsz; u.kt0 = 0; u.nkt = nkt; u.mode = 0; return true;
    }
    __device__ __forceinline__ void a_ready(const Unit&) const {}
    __device__ __forceinline__ void done(const Unit&) const {}
};

struct StaggerOrder : StaticOrder {
    int stag, n;
    __host__ __device__ void init2(int M, int N, int G_, int c_, int stag_, int K = 1024) { init(M, N, G_, c_, K); stag = stag_; n = (nwg - c + G - 1) / G; if (n < 2 || (nkt & 3)) stag = 0; }
    __host__ __device__ bool next(int i, Unit& u) const {
        if (!stag) return StaticOrder::next(i, u);
        if (i > n) return false;
        if (i == 0) { StaticOrder::next(0, u); u.nkt = nkt / 2; u.mode = 1; return true; }
        if (i == n) { StaticOrder::next(0, u); u.kt0 = nkt / 2; u.nkt = nkt / 2; u.mode = 2; return true; }
        return StaticOrder::next(i, u);
    }
};

#ifndef USE_F16
#define USE_F16 0
#endif
typedef _Float16 h16x2 __attribute__((ext_vector_type(2)));
typedef _Float16 h16x8 __attribute__((ext_vector_type(8)));
typedef float f32x2p __attribute__((ext_vector_type(2)));
#if USE_F16
__device__ __forceinline__ unsigned cvt_pk_bf16(float lo, float hi) { const f32x2p v = {lo, hi}; return __builtin_bit_cast(unsigned, __builtin_convertvector(v, h16x2)); }
__device__ __forceinline__ float bflo(unsigned w) { return (float)__builtin_bit_cast(h16x2, w)[0]; }
__device__ __forceinline__ float bfhi(unsigned w) { return (float)__builtin_bit_cast(h16x2, w)[1]; }
__device__ __forceinline__ f32x4 mfma16(bf16x8 a, bf16x8 b, f32x4 c) { return __builtin_amdgcn_mfma_f32_16x16x32_f16(__builtin_bit_cast(h16x8, a), __builtin_bit_cast(h16x8, b), c, 0, 0, 0); }
#else
__device__ __forceinline__ unsigned cvt_pk_bf16(float lo, float hi) { unsigned r; asm volatile("v_cvt_pk_bf16_f32 %0, %1, %2" : "=v"(r) : "v"(lo), "v"(hi)); return r; }
__device__ __forceinline__ float bflo(unsigned w) { return __uint_as_float(w << 16); }
__device__ __forceinline__ float bfhi(unsigned w) { return __uint_as_float(w & 0xffff0000u); }
__device__ __forceinline__ f32x4 mfma16(bf16x8 a, bf16x8 b, f32x4 c) { return __builtin_amdgcn_mfma_f32_16x16x32_bf16(a, b, c, 0, 0, 0); }
#endif
__device__ __forceinline__ float sigmoidf_(float x) { return __builtin_amdgcn_rcpf(1.0f + __builtin_amdgcn_exp2f(-1.4426950408889634f * x)); }
__device__ __forceinline__ f32x4 sig4(f32x4 v) { return (f32x4){sigmoidf_(v[0]), sigmoidf_(v[1]), sigmoidf_(v[2]), sigmoidf_(v[3])}; }
__device__ __forceinline__ u32x4 pack8(f32x4 v0, f32x4 v1) { u32x4 w; w.x = cvt_pk_bf16(v0[0], v0[1]); w.y = cvt_pk_bf16(v0[2], v0[3]); w.z = cvt_pk_bf16(v1[0], v1[1]); w.w = cvt_pk_bf16(v1[2], v1[3]); return w; }
__device__ __forceinline__ void unpack8(u32x4 w, f32x4& v0, f32x4& v1) { v0 = (f32x4){bflo(w.x), bfhi(w.x), bflo(w.y), bfhi(w.y)}; v1 = (f32x4){bflo(w.z), bfhi(w.z), bflo(w.w), bfhi(w.w)}; }

constexpr float QSCALE = 0.125f * 1.4426950408889634f;

struct EpiIn {
    static constexpr bool PERM = true, AFTER_DRAIN = false;
    bf16_t *Q, *Kb, *Vb, *SZSB, *U, *SZCV, *SGSB, *SGCV; int dry;
    __device__ __forceinline__ void operator()(const f32x4 (&acc)[2][2][4][2], const Unit& u, int wr, int wc, int fr, int fq) const {
        const int row0 = u.pm * BM + wr * 64 + fr; const int pn = u.pn;
        if (pn >= 16 && pn < 24) {
            bf16_t* base = U + (pn - 16) * 128 + wc * 32 + 8 * fq;
#pragma unroll
            for (int ai = 0; ai < 2; ++ai)
#pragma unroll
                for (int m = 0; m < 4; ++m) { bf16_t* rowp = base + (size_t)(row0 + ai * HALF + m * 16) * 1024;
                    const f32x4 v0 = acc[ai][0][m][0] * sig4(acc[ai][1][m][0]), v1 = acc[ai][0][m][1] * sig4(acc[ai][1][m][1]);
                    const u32x4 pk = pack8(v0, v1); if (!dry) *(u32x4*)rowp = pk; }
            return;
        }
        const int grp = pn >> 2; int mode; bf16_t* base;
        float sc = 1.f;
        if (grp == 0) { base = Q; mode = 0; sc = QSCALE; } else if (grp == 1) { base = Kb; mode = 0; } else if (grp == 2) { base = Vb; mode = 0; }
        else if (grp == 3) { base = SZSB; mode = 1; } else if (grp == 6) { base = SZCV; mode = 1; } else if (grp == 7) { base = SGSB; mode = 2; } else { base = SGCV; mode = 2; }
        base += (pn & 3) * BM + wc * 32 + 8 * fq;
#pragma unroll
        for (int ai = 0; ai < 2; ++ai)
#pragma unroll
            for (int m = 0; m < 4; ++m) { bf16_t* rowp = base + (size_t)(row0 + ai * HALF + m * 16) * 1024;
#pragma unroll
                for (int bj = 0; bj < 2; ++bj) { f32x4 v0 = acc[ai][bj][m][0], v1 = acc[ai][bj][m][1];
                    if (mode == 0) { v0 = v0 * sc; v1 = v1 * sc; }
                    else if (mode == 1) { v0 = v0 * sig4(v0); v1 = v1 * sig4(v1); }
                    else { v0 = sig4(v0); v1 = sig4(v1); }
                    const u32x4 pk = pack8(v0, v1); if (!dry) *(u32x4*)(rowp + bj * HALF) = pk; } }
    }
};
struct EpiGate {
    static constexpr bool PERM = true, AFTER_DRAIN = false;
    const bf16_t* G; bf16_t* P;
    __device__ __forceinline__ void operator()(const f32x4 (&acc)[2][2][4][2], const Unit& u, int wr, int wc, int fr, int fq) const {
        const int row0 = u.pm * BM + wr * 64 + fr, col0 = u.pn * BM + wc * 32 + 8 * fq;
#pragma unroll
        for (int ai = 0; ai < 2; ++ai)
#pragma unroll
            for (int m = 0; m < 4; ++m) { const size_t off = (size_t)(row0 + ai * HALF + m * 16) * 1024 + col0;
#pragma unroll
                for (int bj = 0; bj < 2; ++bj) { f32x4 g0, g1; unpack8(*(const u32x4*)(G + off + bj * HALF), g0, g1);
                    *(u32x4*)(P + off + bj * HALF) = pack8(acc[ai][bj][m][0] * g0, acc[ai][bj][m][1] * g1); } }
    }
};
struct EpiGateAdd {
    static constexpr bool PERM = true, AFTER_DRAIN = false;
    const bf16_t* G; const bf16_t* P; bf16_t* O;
    __device__ __forceinline__ void operator()(const f32x4 (&acc)[2][2][4][2], const Unit& u, int wr, int wc, int fr, int fq) const {
        const int row0 = u.pm * BM + wr * 64 + fr, col0 = u.pn * BM + wc * 32 + 8 * fq;
#pragma unroll
        for (int ai = 0; ai < 2; ++ai)
#pragma unroll
            for (int m = 0; m < 4; ++m) { const size_t off = (size_t)(row0 + ai * HALF + m * 16) * 1024 + col0;
#pragma unroll
                for (int bj = 0; bj < 2; ++bj) { f32x4 g0, g1, p0, p1; unpack8(*(const u32x4*)(G + off + bj * HALF), g0, g1); unpack8(*(const u32x4*)(P + off + bj * HALF), p0, p1);
                    *(u32x4*)(O + off + bj * HALF) = pack8(p0 + acc[ai][bj][m][0] * g0, p1 + acc[ai][bj][m][1] * g1); } }
    }
};
struct EpiOut {
    static constexpr bool PERM = false, AFTER_DRAIN = false;
    const float* x; const float* stats; const float* g; const float* b; float* C; float alpha;
    __device__ __forceinline__ void operator()(const f32x4 (&acc)[2][2][4][2], const Unit& u, int wr, int wc, int fr, int fq) const {
        const int row0 = u.pm * BM + wr * 64 + fr, col0 = u.pn * BM + wc * 32 + 4 * fq;
        f32x4 gv[2][2], bv[2][2];
#pragma unroll
        for (int bj = 0; bj < 2; ++bj)
#pragma unroll
            for (int n = 0; n < 2; ++n) { gv[bj][n] = *(const f32x4*)(g + col0 + bj * HALF + n * 16) * alpha; bv[bj][n] = *(const f32x4*)(b + col0 + bj * HALF + n * 16) * alpha; }
#pragma unroll
        for (int ai = 0; ai < 2; ++ai)
#pragma unroll
            for (int m = 0; m < 4; ++m) { const int row = row0 + ai * HALF + m * 16; const size_t off = (size_t)row * 1024 + col0;
                const float mu = stats[2 * row], rs = stats[2 * row + 1];
#pragma unroll
                for (int bj = 0; bj < 2; ++bj)
#pragma unroll
                    for (int n = 0; n < 2; ++n) { const f32x4 xv = *(const f32x4*)(x + off + bj * HALF + n * 16);
                        *(f32x4*)(C + off + bj * HALF + n * 16) = ((xv - mu) * rs) * gv[bj][n] + bv[bj][n] + acc[ai][bj][m][n]; } }
    }
};

template <class Epi, class Sched, bool ALIGN_EPI = false, bool SP2 = false>
__device__ __forceinline__ void gemm_phase(PG8_LAS unsigned char* lds, const Gemm g, const Sched& S, const Epi& E, f32x4* part = nullptr) {
    const int tid = threadIdx.x, wid = __builtin_amdgcn_readfirstlane(tid >> 6), lane = tid & 63, wr = wid >> 2, wc = wid & 3, fr = lane & 15, fq = lane >> 4;
    const int K = g.K;
    unsigned voffA[2], voffB[2];
#pragma unroll
    for (int i = 0; i < 2; ++i) { int R, C; stage_rc(tid * 16 + i * 8192, R, C); const int Rb = Epi::PERM ? ((R & ~31) + perm32(R & 31)) : R;
        voffA[i] = (unsigned)(R * K + C) * 2u; voffB[i] = (unsigned)(Rb * K + C) * 2u; }
    const size_t kstep = (size_t)(BK * 2);
    const size_t hstep = (size_t)HALF * K * 2;
    const size_t tstep = 2 * hstep;
    const unsigned ldsw = (unsigned)wid * 1024u;
    const int aoff = lds_byte(wr * 64 + fr, fq * 8), boff = lds_byte(wc * 32 + fr, fq * 8);
#define PG8_SA(b, h) (((b) * 2 + (h)) * HTB)
#define PG8_SB(b, h) ((4 + (b) * 2 + (h)) * HTB)
#define PG8_STAGE(bufoff, gbase, voff) do { _Pragma("unroll") for (int _i = 0; _i < 2; ++_i) \
        __builtin_amdgcn_global_load_lds((const unsigned*)((const char*)(gbase) + (voff)[_i]), (PG8_LAS unsigned*)(lds + (bufoff) + ldsw + _i * 8192), 16, 0, 0); } while (0)
#define PG8_LDA(dst, b, h) do { _Pragma("unroll") for (int m = 0; m < 4; ++m) _Pragma("unroll") for (int k = 0; k < 2; ++k) dst[m][k] = *(const PG8_LAS bf16x8*)(lds + PG8_SA(b, h) + aoff + m * 2048 + k * 1024); } while (0)
#define PG8_LDB(dst, b, h) do { _Pragma("unroll") for (int n = 0; n < 2; ++n) _Pragma("unroll") for (int k = 0; k < 2; ++k) dst[n][k] = *(const PG8_LAS bf16x8*)(lds + PG8_SB(b, h) + boff + n * 2048 + k * 1024); } while (0)
#define PG8_MMA(ai, bj, At, Bt) do { __builtin_amdgcn_s_setprio(1); _Pragma("unroll") for (int m = 0; m < 4; ++m) _Pragma("unroll") for (int n = 0; n < 2; ++n) _Pragma("unroll") for (int k = 0; k < 2; ++k) \
        acc[ai][bj][m][n] = mfma16(Bt[n][k], At[m][k], acc[ai][bj][m][n]); __builtin_amdgcn_s_setprio(0); } while (0)
#define PG8_WAIT_V(n) asm volatile("s_waitcnt vmcnt(" #n ")" ::: "memory")
#define PG8_WAIT_L(n) asm volatile("s_waitcnt lgkmcnt(" #n ")" ::: "memory")
#define PG8_BAR __builtin_amdgcn_s_barrier()
#define PG8_SCHED __builtin_amdgcn_sched_barrier(0)
    Unit cur, nxt; int ui = 0;
    if (!S.next(0, cur)) return;
    f32x4 acc[2][2][4][2];
#pragma unroll
    for (int a = 0; a < 2; ++a)
#pragma unroll
        for (int b = 0; b < 2; ++b)
#pragma unroll
            for (int m = 0; m < 4; ++m)
#pragma unroll
                for (int n = 0; n < 2; ++n) acc[a][b][m][n] = (f32x4){0.f, 0.f, 0.f, 0.f};
    bf16x8 At[4][2], B0[2][2], B1[2][2];
    const char* cA = (const char*)g.A + (size_t)cur.pm * tstep + (size_t)cur.kt0 * (BK * 2); const char* cB = (const char*)g.Bt + (size_t)cur.pn * tstep + (size_t)cur.kt0 * (BK * 2);
    S.a_ready(cur);
    if constexpr (SP2) {
        PG8_STAGE(PG8_SB(0, 0), cB, voffB); PG8_STAGE(PG8_SB(0, 1), cB + hstep, voffB); PG8_STAGE(PG8_SA(0, 0), cA, voffA); PG8_STAGE(PG8_SA(0, 1), cA + hstep, voffA);
        if (wr == 1) PG8_BAR;
        PG8_WAIT_V(2); PG8_BAR;
        PG8_STAGE(PG8_SB(1, 0), cB + kstep, voffB); PG8_STAGE(PG8_SA(1, 0), cA + kstep, voffA); PG8_STAGE(PG8_SB(1, 1), cB + hstep + kstep, voffB);
        PG8_WAIT_V(6); PG8_BAR;
    } else {
        PG8_STAGE(PG8_SB(0, 0), cB, voffB); PG8_STAGE(PG8_SA(0, 0), cA, voffA); PG8_STAGE(PG8_SB(0, 1), cB + hstep, voffB); PG8_STAGE(PG8_SA(0, 1), cA + hstep, voffA);
        if (wr == 1) PG8_BAR;
        PG8_WAIT_V(4); PG8_BAR;
        PG8_STAGE(PG8_SB(1, 0), cB + kstep, voffB); PG8_STAGE(PG8_SA(1, 0), cA + kstep, voffA); PG8_STAGE(PG8_SB(1, 1), cB + hstep + kstep, voffB);
        PG8_WAIT_V(6); PG8_BAR;
    }
    for (;;) {
        const bool has_next = S.next(ui + 1, nxt);
        const char* nA = has_next ? (const char*)g.A + (size_t)nxt.pm * tstep + (size_t)nxt.kt0 * (BK * 2) : cA; const char* nB = has_next ? (const char*)g.Bt + (size_t)nxt.pn * tstep + (size_t)nxt.kt0 * (BK * 2) : cB;
        const int nt = cur.nkt;
        for (int t = 0; t < nt; t += 2) {
            const bool last = (t == nt - 2);
            const char* a1 = cA + (size_t)(t + 1) * kstep;
            const char* a2 = last ? nA : cA + (size_t)(t + 2) * kstep; const char* b2 = last ? nB : cB + (size_t)(t + 2) * kstep;
            const char* a3 = a2 + kstep; const char* b3 = b2 + kstep;
            if (last && has_next) S.a_ready(nxt);
            if constexpr (SP2) {
            PG8_LDB(B0, 0, 0); PG8_LDB(B1, 0, 1); PG8_SCHED; PG8_LDA(At, 0, 0); PG8_STAGE(PG8_SA(1, 1), a1 + hstep, voffA);
            PG8_WAIT_V(8); PG8_WAIT_L(0); PG8_BAR; PG8_MMA(0, 0, At, B0); PG8_MMA(0, 1, At, B1); PG8_BAR; PG8_SCHED;
            PG8_LDA(At, 0, 1); PG8_STAGE(PG8_SB(0, 0), b2, voffB); PG8_STAGE(PG8_SB(0, 1), b2 + hstep, voffB); PG8_STAGE(PG8_SA(0, 0), a2, voffA);
            PG8_WAIT_V(8); PG8_WAIT_L(0); PG8_BAR; PG8_MMA(1, 0, At, B0); PG8_MMA(1, 1, At, B1); PG8_BAR; PG8_SCHED;
            PG8_LDB(B0, 1, 0); PG8_LDB(B1, 1, 1); PG8_SCHED; PG8_LDA(At, 1, 0); PG8_STAGE(PG8_SA(0, 1), a2 + hstep, voffA);
            PG8_WAIT_V(8); PG8_WAIT_L(0); PG8_BAR; PG8_MMA(0, 0, At, B0); PG8_MMA(0, 1, At, B1); PG8_BAR; PG8_SCHED;
            PG8_LDA(At, 1, 1); PG8_STAGE(PG8_SB(1, 0), b3, voffB); PG8_STAGE(PG8_SB(1, 1), b3 + hstep, voffB); PG8_STAGE(PG8_SA(1, 0), a3, voffA);
            PG8_WAIT_V(8); PG8_WAIT_L(0); PG8_BAR; PG8_MMA(1, 0, At, B0); PG8_MMA(1, 1, At, B1); PG8_BAR; PG8_SCHED;
            } else {
            PG8_LDB(B0, 0, 0); PG8_SCHED; PG8_LDA(At, 0, 0); PG8_STAGE(PG8_SA(1, 1), a1 + hstep, voffA);
            PG8_WAIT_L(8); PG8_BAR; PG8_WAIT_L(0); PG8_MMA(0, 0, At, B0); PG8_BAR; PG8_SCHED;
            PG8_LDB(B1, 0, 1); PG8_STAGE(PG8_SB(0, 0), b2, voffB);
            PG8_BAR; PG8_WAIT_L(0); PG8_MMA(0, 1, At, B1); PG8_BAR;
            PG8_LDA(At, 0, 1); PG8_STAGE(PG8_SA(0, 0), a2, voffA);
            PG8_BAR; PG8_WAIT_L(0); PG8_MMA(1, 0, At, B0); PG8_BAR; PG8_SCHED;
            PG8_STAGE(PG8_SB(0, 1), b2 + hstep, voffB);
            PG8_WAIT_V(6); PG8_BAR; PG8_MMA(1, 1, At, B1); PG8_BAR;
            PG8_LDB(B0, 1, 0); PG8_SCHED; PG8_LDA(At, 1, 0); PG8_STAGE(PG8_SA(0, 1), a2 + hstep, voffA);
            PG8_WAIT_L(8); PG8_BAR; PG8_WAIT_L(0); PG8_MMA(0, 0, At, B0); PG8_BAR; PG8_SCHED;
            PG8_LDB(B1, 1, 1); PG8_STAGE(PG8_SB(1, 0), b3, voffB);
            PG8_BAR; PG8_WAIT_L(0); PG8_MMA(0, 1, At, B1); PG8_BAR;
            PG8_LDA(At, 1, 1); PG8_STAGE(PG8_SA(1, 0), a3, voffA);
            PG8_BAR; PG8_WAIT_L(0); PG8_MMA(1, 0, At, B0); PG8_BAR; PG8_SCHED;
            PG8_STAGE(PG8_SB(1, 1), b3 + hstep, voffB);
            PG8_WAIT_V(6); PG8_BAR; PG8_MMA(1, 1, At, B1); PG8_BAR;
            }
        }
        if constexpr (ALIGN_EPI) { if (wr == 0) PG8_BAR; }
        if (cur.mode == 1) {
            __attribute__((address_space(1))) f32x4* pp = (__attribute__((address_space(1))) f32x4*)part + tid;
#pragma unroll
            for (int a = 0; a < 2; ++a)
#pragma unroll
                for (int b = 0; b < 2; ++b)
#pragma unroll
                    for (int m = 0; m < 4; ++m)
#pragma unroll
                        for (int n = 0; n < 2; ++n) { *pp = acc[a][b][m][n]; pp += 512; asm volatile("" : "+v"(pp)); }
        } else
        if constexpr (!Epi::AFTER_DRAIN) { E(acc, cur, wr, wc, fr, fq); S.done(cur); }
        if (!has_next) break;
        if (nxt.mode == 2) {
            const __attribute__((address_space(1))) f32x4* pp = (const __attribute__((address_space(1))) f32x4*)part + tid;
#pragma unroll
            for (int a = 0; a < 2; ++a)
#pragma unroll
                for (int b = 0; b < 2; ++b)
#pragma unroll
                    for (int m = 0; m < 4; ++m)
#pragma unroll
                        for (int n = 0; n < 2; ++n) { acc[a][b][m][n] = *pp; pp += 512; asm volatile("" : "+v"(pp)); }
        } else {
#pragma unroll
        for (int a = 0; a < 2; ++a)
#pragma unroll
            for (int b = 0; b < 2; ++b)
#pragma unroll
                for (int m = 0; m < 4; ++m)
#pragma unroll
                    for (int n = 0; n < 2; ++n) acc[a][b][m][n] = (f32x4){0.f, 0.f, 0.f, 0.f};
        }
        cur = nxt; cA = nA; cB = nB; ++ui;
        if constexpr (ALIGN_EPI) { if (wr == 1) PG8_BAR; }
    }
    PG8_WAIT_V(0);
    if constexpr (!ALIGN_EPI) { if (wr == 0) PG8_BAR; }
    PG8_BAR;
    if constexpr (Epi::AFTER_DRAIN) { E.fused(acc, cur, wr, wc, fr, fq, lds, wid, lane); S.done(cur); }
#undef PG8_SA
#undef PG8_SB
#undef PG8_STAGE
#undef PG8_LDA
#undef PG8_LDB
#undef PG8_MMA
#undef PG8_WAIT_V
#undef PG8_WAIT_L
#undef PG8_BAR
#undef PG8_SCHED
}
}

constexpr int NWAVES = 8;
constexpr int NB = 16, SEQ = 2048, D = 1024, NH = 16, HD = 64, NIN = 9216, CVK = 31;
constexpr int M = NB * SEQ;
constexpr float LN_EPS = 1e-5f;
constexpr float DN_ALPHA = 1.189207115002721f;

constexpr size_t MiB = 1u << 20;
constexpr size_t WS_CTL = 0;
constexpr size_t WS_STATS = 1 * MiB;
constexpr size_t WS_WIN = 2 * MiB;
constexpr size_t WS_WSB = 20 * MiB, WS_WCV = 22 * MiB, WS_WOUT = 24 * MiB;
constexpr size_t WS_K = 32 * MiB, WS_V = 96 * MiB, WS_SZSB = 160 * MiB, WS_U = 224 * MiB, WS_SZCV = 288 * MiB, WS_SGSB = 352 * MiB, WS_SGCV = 416 * MiB, WS_PART = 480 * MiB, WS_END = 512 * MiB;
constexpr size_t WS_MERGED = WS_K;
constexpr size_t WS_P = WS_V;

constexpr int LDS_BYTES = 147456;
constexpr int BAR_LDS_OFF = 139264;
constexpr int CW_BAR = 4096;
constexpr size_t CTL_ZERO_BYTES = 65536;

#define GAS __attribute__((address_space(1)))
#define LAS __attribute__((address_space(3)))
typedef unsigned short bf16;
typedef unsigned v4u __attribute__((ext_vector_type(4)));
typedef float f32x4 __attribute__((ext_vector_type(4)));
#define LDS_WAIT() asm volatile("s_waitcnt lgkmcnt(0)" ::: "memory")
__device__ __forceinline__ unsigned pk2(float lo, float hi) { return pg8::cvt_pk_bf16(lo, hi); }
__device__ __forceinline__ unsigned f2bf(float f) { return pk2(f, 0.f) & 0xffffu; }
__device__ __forceinline__ float bf2f(unsigned b) { return pg8::bflo(b); }

struct Frame {
    LAS unsigned char* lds;
    int tid, lane, wave, G, bid;
    const float *x, *ln_in_g, *ln_in_b, *w_in, *w_sb, *conv_w, *conv_b, *cln_g, *cln_b, *w_cv, *w_out, *lnp_g, *lnp_b;
    float* out; float* stats;
    bf16 *WIN, *WSB, *WCV, *WOUT, *XN, *ASB, *Q, *K, *V, *SZSB, *U, *SZCV, *SGSB, *SGCV, *MERGED, *P;
};

__device__ __forceinline__ float wave_sum(float v) {
#pragma unroll
    for (int o = 1; o < 64; o <<= 1) v += __shfl_xor(v, o);
    return v;
}
#define XB_TMO      128
#define XB_XCNT(j)  (256  + 64 * (j))
#define XB_XSUB(j)  (1280 + 64 * (j))
#define XB_XGEN(j)  (2304 + 64 * (j))
#define XB_TOP      3328
#define XB_TOPGEN   3392
#define XCD_BAR_WORDS 3456
#define XB_SPIN_CAP (1u << 18)

__device__ __forceinline__ unsigned xb_ld(unsigned* p)              { return __hip_atomic_load(p, __ATOMIC_RELAXED, __HIP_MEMORY_SCOPE_AGENT); }
__device__ __forceinline__ unsigned xb_add(unsigned* p, unsigned v) { return __hip_atomic_fetch_add(p, v, __ATOMIC_RELAXED, __HIP_MEMORY_SCOPE_AGENT); }
__device__ __forceinline__ unsigned xb_xcc_id() { return (unsigned)__builtin_amdgcn_s_getreg((3 << 11) | 20) & 0xFu; }
#define XB_SPIN(cond, bar) do { unsigned _sp = 0; while (cond) { __builtin_amdgcn_s_sleep(1); \
    if ((++_sp & 255u) == 0u) { if (xb_ld(&(bar)[XB_TMO])) break; if (_sp > XB_SPIN_CAP) { atomicAdd(&(bar)[XB_TMO], 1u); break; } } } } while (0)

struct XcdBarrier {
    unsigned* bar; unsigned x;
    volatile LAS unsigned* st;
};

__device__ __forceinline__ XcdBarrier xcd_barrier_post(unsigned* bar, volatile LAS unsigned* st) {
    XcdBarrier b; b.bar = bar; b.x = xb_xcc_id(); b.st = st;
    if (threadIdx.x == 0) (void)xb_add(&bar[XB_XCNT(b.x)], 1u);
    return b;
}
__device__ __forceinline__ void xcd_barrier_complete(unsigned* bar, unsigned x, unsigned& nloc, unsigned& nx) {
    const unsigned G = gridDim.x * gridDim.y * gridDim.z;
    unsigned sum, cnt, mine, sp = 0u;
    for (;;) {
        sum = 0u; cnt = 0u; mine = 0u;
#pragma unroll
        for (unsigned j = 0; j < 16; ++j) { const unsigned c = xb_ld(&bar[XB_XCNT(j)]); sum += c; cnt += (c > 0u) ? 1u : 0u; mine = (j == x) ? c : mine; }
        if (sum == G) break;
        __builtin_amdgcn_s_sleep(1);
        if ((++sp & 255u) == 0u) { if (xb_ld(&bar[XB_TMO])) break; if (sp > XB_SPIN_CAP) { atomicAdd(&bar[XB_TMO], 1u); break; } }
    }
    nloc = mine > 0u ? mine : 1u; nx = cnt > 0u ? cnt : 1u;
}

__device__ __forceinline__ void xcd_barrier(const XcdBarrier& b) {
    asm volatile("s_waitcnt vmcnt(0)" ::: "memory");
    __syncthreads();
    if (threadIdx.x == 0) {
        unsigned* bar = b.bar;
        __builtin_amdgcn_s_waitcnt(0);
        unsigned nloc = b.st[0], nx = b.st[1];
        if (nloc == 0u) { xcd_barrier_complete(bar, b.x, nloc, nx); b.st[0] = nloc; b.st[1] = nx; }
        const unsigned old = xb_add(&bar[XB_XSUB(b.x)], 1u);
        const unsigned gen = old / nloc;
        if (old + 1u == (gen + 1u) * nloc) {
            __builtin_amdgcn_fence(__ATOMIC_RELEASE, "agent");
            asm volatile("s_waitcnt vmcnt(0)" ::: "memory");
            const unsigned og = xb_add(&bar[XB_TOP], 1u);
            const unsigned tg = og / nx;
            if (og + 1u == (tg + 1u) * nx) xb_add(&bar[XB_TOPGEN], 1u);
            else XB_SPIN(xb_ld(&bar[XB_TOPGEN]) == tg, bar);
            __builtin_amdgcn_fence(__ATOMIC_ACQUIRE, "agent");
            xb_add(&bar[XB_XGEN(b.x)], 1u);
            asm volatile("s_waitcnt vmcnt(0)" ::: "memory");
        } else {
            XB_SPIN(xb_ld(&bar[XB_XGEN(b.x)]) == gen, bar);
            __builtin_amdgcn_fence(__ATOMIC_ACQUIRE, "agent");
            asm volatile("s_waitcnt vmcnt(0)" ::: "memory");
        }
    }
    __syncthreads();
}

__device__ __forceinline__ void p0_transpose_item(const float* W, int K, int N, bf16* WT, int dst_row0, int src_col0, int kb, LAS float* scr, int lane) {
    const int k0 = 64 * kb;
#pragma unroll 8
    for (int i = 0; i < 32; ++i) { const int kk = 2 * i + (lane >> 5); scr[kk * 33 + (lane & 31)] = W[(size_t)(k0 + kk) * N + src_col0 + (lane & 31)]; }
    LDS_WAIT(); asm volatile("" ::: "memory");
    const int c = lane & 7;
#pragma unroll
    for (int j = 0; j < 4; ++j) { const int n = (lane >> 3) + 8 * j; const LAS float* s = scr + (8 * c) * 33 + n;
        v4u o; o.x = pk2(s[0 * 33], s[1 * 33]); o.y = pk2(s[2 * 33], s[3 * 33]); o.z = pk2(s[4 * 33], s[5 * 33]); o.w = pk2(s[6 * 33], s[7 * 33]);
        *(GAS v4u*)(WT + (size_t)(dst_row0 + n) * K + k0 + 8 * c) = o; }
    LDS_WAIT(); asm volatile("" ::: "memory");
}
__device__ __forceinline__ int win_src_col(int n) {
    if (n < 4096 || n >= 6144) return n;
    const int r = n - 4096, j = r >> 8, q = r & 255;
    return q < 128 ? 4096 + 128 * j + q : 5120 + 128 * j + (q - 128);
}
__device__ __forceinline__ void p0_prologue(Frame& F) {
    LAS float* scr = (LAS float*)(F.lds + F.wave * 16384);
    const int gw = F.bid * NWAVES + F.wave, NGW = F.G * NWAVES;
    constexpr int I_IN = (D / 64) * (NIN / 32), I_SQ = (D / 64) * (D / 32);
    for (int it = gw; it < I_IN + 3 * I_SQ; it += NGW) {
        int r = it;
        if (r < I_IN) { const int kb = r / (NIN / 32), nb = r % (NIN / 32); p0_transpose_item(F.w_in, D, NIN, F.WIN, 32 * nb, win_src_col(32 * nb), kb, scr, F.lane); continue; } r -= I_IN;
        if (r < I_SQ) { p0_transpose_item(F.w_sb, D, D, F.WSB, 32 * (r % (D / 32)), 32 * (r % (D / 32)), r / (D / 32), scr, F.lane); continue; } r -= I_SQ;
        if (r < I_SQ) { p0_transpose_item(F.w_cv, D, D, F.WCV, 32 * (r % (D / 32)), 32 * (r % (D / 32)), r / (D / 32), scr, F.lane); continue; } r -= I_SQ;
        p0_transpose_item(F.w_out, D, D, F.WOUT, 32 * (r % (D / 32)), 32 * (r % (D / 32)), r / (D / 32), scr, F.lane);
    }
    for (int m = gw; m < M; m += NGW) {
        const GAS f32x4* xr = (const GAS f32x4*)(F.x + (size_t)m * D) + F.lane;
        f32x4 v[4]; float s = 0.f;
#pragma unroll
        for (int j = 0; j < 4; ++j) { v[j] = xr[64 * j]; s += (v[j].x + v[j].y) + (v[j].z + v[j].w); }
        const float mean = wave_sum(s) * (1.f / D); float s2 = 0.f;
#pragma unroll
        for (int j = 0; j < 4; ++j) { const f32x4 d = v[j] - mean; s2 += (d.x * d.x + d.y * d.y) + (d.z * d.z + d.w * d.w); }
        const float rstd = 1.f / sqrtf(wave_sum(s2) * (1.f / D) + LN_EPS);
        if (F.lane == 0) { F.stats[2 * m] = mean; F.stats[2 * m + 1] = rstd; }
        GAS unsigned long long* o8 = (GAS unsigned long long*)(F.XN + (size_t)m * D) + F.lane;
#pragma unroll
        for (int j = 0; j < 4; ++j) { const f32x4 g = *((const GAS f32x4*)F.ln_in_g + F.lane + 64 * j), b = *((const GAS f32x4*)F.ln_in_b + F.lane + 64 * j);
            const f32x4 y = ((v[j] - mean) * rstd) * g + b;
            o8[64 * j] = (unsigned long long)pk2(y.x, y.y) | ((unsigned long long)pk2(y.z, y.w) << 32); }
    }
}

__device__ __forceinline__ void attn_ref_task(Frame& F, int row, int h) {
    const int lane = F.lane; const int t = row & (SEQ - 1); const int rowb = row - t;
    float qd[64];
    { const GAS v4u* qp = (const GAS v4u*)(F.Q + (size_t)row * D + h * HD);
#pragma unroll
      for (int i = 0; i < 8; ++i) { const v4u w = qp[i]; qd[8 * i + 0] = bf2f(w.x & 0xffffu); qd[8 * i + 1] = bf2f(w.x >> 16); qd[8 * i + 2] = bf2f(w.y & 0xffffu); qd[8 * i + 3] = bf2f(w.y >> 16);
          qd[8 * i + 4] = bf2f(w.z & 0xffffu); qd[8 * i + 5] = bf2f(w.z >> 16); qd[8 * i + 6] = bf2f(w.w & 0xffffu); qd[8 * i + 7] = bf2f(w.w >> 16); } }
    float o = 0.f, carry = 0.f;
    for (int j = (t - 1) >> 6; j >= 0; --j) {
        const int s = 64 * j + lane;
        const GAS v4u* kp = (const GAS v4u*)(F.K + (size_t)(rowb + s) * D + h * HD);
        float xs = 0.f;
#pragma unroll
        for (int i = 0; i < 8; ++i) { const v4u w = kp[i];
            xs += qd[8 * i + 0] * bf2f(w.x & 0xffffu); xs += qd[8 * i + 1] * bf2f(w.x >> 16); xs += qd[8 * i + 2] * bf2f(w.y & 0xffffu); xs += qd[8 * i + 3] * bf2f(w.y >> 16);
            xs += qd[8 * i + 4] * bf2f(w.z & 0xffffu); xs += qd[8 * i + 5] * bf2f(w.z >> 16); xs += qd[8 * i + 6] * bf2f(w.w & 0xffffu); xs += qd[8 * i + 7] * bf2f(w.w >> 16); }
        const bool valid = s < t;
        const float sp = valid ? (fmaxf(xs, 0.f) + __builtin_amdgcn_logf(1.0f + __builtin_amdgcn_exp2f(-fabsf(xs)))) : 0.f;
        float suf = sp;
#pragma unroll
        for (int off = 1; off < 64; off <<= 1) { const float v = __shfl_down(suf, off); if (lane + off < 64) suf += v; }
        const float w = valid ? __builtin_amdgcn_exp2f(xs - (suf + carry)) : 0.f;
        carry += __shfl(suf, 0);
        const GAS bf16* vp = (const GAS bf16*)(F.V + (size_t)(rowb + 64 * j) * D + h * HD + lane);
        for (int i = 0; i < 64; ++i) { const float wi = __shfl(w, i); o += wi * bf2f(vp[(size_t)i * D]); }
    }
    const size_t oo = (size_t)row * D + h * HD + lane;
    const float sz = bf2f(F.SZSB[oo]);
    F.ASB[oo] = (bf16)f2bf(o * sz);
}
__device__ __forceinline__ void attn_ref_phase(Frame& F) {
    const int gw = F.bid * NWAVES + F.wave, NGW = F.G * NWAVES;
    for (int it = gw; it < M * NH; it += NGW) attn_ref_task(F, it >> 4, it & 15);
}

namespace sba {
using f32x16 = __attribute__((ext_vector_type(16))) float;
using bf16x8 = __attribute__((ext_vector_type(8))) short;
using s16x4 = __attribute__((ext_vector_type(4))) short;
typedef short v4i16_t __attribute__((ext_vector_type(4)));
constexpr int VDH = 4160;
constexpr int WBYTES = 8448;
constexpr float ATT_EXIT = 1.0e-9f;

__device__ __forceinline__ unsigned cvtpk(float lo, float hi) { return pg8::cvt_pk_bf16(lo, hi); }
#if USE_F16
__device__ __forceinline__ f32x16 mfma32(bf16x8 a, bf16x8 b, f32x16 c) { return __builtin_amdgcn_mfma_f32_32x32x16_f16(__builtin_bit_cast(pg8::h16x8, a), __builtin_bit_cast(pg8::h16x8, b), c, 0, 0, 0); }
#else
__device__ __forceinline__ f32x16 mfma32(bf16x8 a, bf16x8 b, f32x16 c) { return __builtin_amdgcn_mfma_f32_32x32x16_bf16(a, b, c, 0, 0, 0); }
#endif
__device__ __forceinline__ s16x4 vtr(LAS unsigned char* p) { return __builtin_bit_cast(s16x4, __builtin_amdgcn_ds_read_tr16_b64_v4i16((LAS v4i16_t*)p)); }

template <bool MASK>
__device__ __forceinline__ void tile_weights(const f32x16& p0, const f32x16& p1, float (&w)[32], float& carry, int kv0, int start, int r32, int hi) {
    float e[32], c[32], G[8];
    const int hiLim = r32 - kv0 - 4 * hi, loLim = -start - 4 * hi;
#pragma unroll
    for (int idx = 0; idx < 32; ++idx) { const int kvc = (idx >= 16 ? 32 : 0) + (idx & 3) + 8 * ((idx & 15) >> 2);
        float xv = fminf(idx < 16 ? p0[idx] : p1[idx - 16], 64.f);
        if (MASK) xv = (kvc < hiLim && kvc >= loLim) ? xv : -1000.f;
        e[idx] = __builtin_amdgcn_exp2f(xv); }
#pragma unroll
    for (int g = 0; g < 8; ++g) {
        float s = 1.f;
#pragma unroll
        for (int k = 3; k >= 0; --k) { const int idx = 4 * g + k; const float r = __builtin_amdgcn_rcpf(1.0f + e[idx]); s = (k == 3) ? r : s * r; c[idx] = s; }
        G[g] = s;
    }
    float run = carry;
#pragma unroll
    for (int g = 7; g >= 0; --g) {
        const auto rr = __builtin_amdgcn_permlane32_swap(__float_as_uint(G[g]), __float_as_uint(G[g]), false, false);
        const float ev = __uint_as_float(rr[0]), od = __uint_as_float(rr[1]);
        const float tmp = run * od; const float off = hi ? run : tmp; run = tmp * ev;
#pragma unroll
        for (int k = 0; k < 4; ++k) { const int idx = 4 * g + k; w[idx] = e[idx] * (off * c[idx]); }
    }
    carry = run;
}

__device__ __forceinline__ void attn_task(Frame& F, int b, int h, int qblk, LAS unsigned char* vl) {
    const int lane = F.lane, r32 = lane & 31, hi = lane >> 5;
    const int tw = 32 * qblk; const size_t rowb = (size_t)b * SEQ;
    const bf16* Qw = F.Q + (rowb + tw) * D + h * HD;
    const bf16* Kh = F.K + rowb * D + h * HD + hi * 8; const bf16* Vh = F.V + rowb * D + h * HD + (lane & 7) * 8;
    bf16x8 qr[4];
#pragma unroll
    for (int d0 = 0; d0 < 4; ++d0) qr[d0] = *(const GAS bf16x8*)(Qw + (size_t)r32 * D + d0 * 16 + hi * 8);
    f32x16 o[2]; o[0] = f32x16{}; o[1] = f32x16{};
    float carry = 1.f;
    LAS unsigned char* vwr = vl + ((lane & 7) >> 2) * VDH + (lane >> 3) * 64 + (lane & 3) * 16;
    LAS unsigned char* vrd = vl + ((lane >> 4) & 1) * 32 + (lane & 3) * 8 + (4 * hi + ((lane & 15) >> 2)) * 64;
    bf16x8 kf[2][4]; v4u vr[8];
#define SBA_LOAD(st) do { \
        _Pragma("unroll") for (int hh = 0; hh < 2; ++hh) { int kr = (st) + 32 * hh + r32; kr = kr < 0 ? 0 : kr; \
            _Pragma("unroll") for (int d0 = 0; d0 < 4; ++d0) kf[hh][d0] = *(const GAS bf16x8*)(Kh + (size_t)kr * D + d0 * 16); } \
        _Pragma("unroll") for (int it = 0; it < 8; ++it) { int vrw = (st) + 8 * it + (lane >> 3); vrw = vrw < 0 ? 0 : vrw; vr[it] = *(const GAS v4u*)(Vh + (size_t)vrw * D); } } while (0)
    SBA_LOAD(tw - 32);
    for (int i = 0;; ++i) {
        const int start = tw - 32 - 64 * i;
        f32x16 p0 = f32x16{}, p1 = f32x16{};
#pragma unroll
        for (int d0 = 0; d0 < 4; ++d0) { p0 = mfma32(kf[0][d0], qr[d0], p0); p1 = mfma32(kf[1][d0], qr[d0], p1); }
#pragma unroll
        for (int it = 0; it < 8; ++it) *(LAS v4u*)(vwr + it * 512) = vr[it];
        SBA_LOAD(start - 64);
        float w[32];
        if (i == 0 || start < 0) tile_weights<true>(p0, p1, w, carry, start - tw, start, r32, hi);
        else tile_weights<false>(p0, p1, w, carry, start - tw, start, r32, hi);
        bf16x8 pa[4];
#pragma unroll
        for (int ks = 0; ks < 4; ++ks) { v4u t; t.x = cvtpk(w[8 * ks + 0], w[8 * ks + 1]); t.y = cvtpk(w[8 * ks + 2], w[8 * ks + 3]); t.z = cvtpk(w[8 * ks + 4], w[8 * ks + 5]); t.w = cvtpk(w[8 * ks + 6], w[8 * ks + 7]); pa[ks] = __builtin_bit_cast(bf16x8, t); }
#pragma unroll
        for (int d0 = 0; d0 < 2; ++d0)
#pragma unroll
            for (int ks = 0; ks < 4; ++ks) { const s16x4 lo = vtr(vrd + d0 * VDH + ks * 1024), hi4 = vtr(vrd + d0 * VDH + ks * 1024 + 512);
                const bf16x8 vf = (bf16x8){lo[0], lo[1], lo[2], lo[3], hi4[0], hi4[1], hi4[2], hi4[3]};
                o[d0] = mfma32(pa[ks], vf, o[d0]); }
        if (start - 64 <= -64 || __all(carry < ATT_EXIT)) break;
    }
#undef SBA_LOAD
    LAS float* stg = (LAS float*)vl;
#pragma unroll
    for (int r = 0; r < 16; ++r) { const int q = (r & 3) + 8 * (r >> 2) + 4 * hi;
#pragma unroll
        for (int d0 = 0; d0 < 2; ++d0) stg[q * 64 + d0 * 32 + r32] = o[d0][r]; }
    const bf16* Zw = F.SZSB + (rowb + tw) * D + h * HD; bf16* Ow = F.ASB + (rowb + tw) * D + h * HD;
#pragma unroll
    for (int it = 0; it < 4; ++it) { const int row = it * 8 + (lane >> 3), ch = lane & 7;
        const f32x4 a0 = *(const LAS f32x4*)(stg + row * 64 + ch * 8), a1 = *(const LAS f32x4*)(stg + row * 64 + ch * 8 + 4);
        pg8::f32x4 z0, z1; pg8::unpack8(*(const GAS pg8::u32x4*)(Zw + (size_t)row * D + ch * 8), z0, z1);
        *(GAS pg8::u32x4*)(Ow + (size_t)row * D + ch * 8) = pg8::pack8(a0 * z0, a1 * z1); }
}
__device__ __forceinline__ void attn_phase(Frame& F) {
    LAS unsigned char* vl = F.lds + F.wave * WBYTES;
    for (int it = 0;; ++it) {
        const int tsk = (it * F.G + F.bid) * NWAVES + F.wave;
        if (tsk >= NB * NH * (SEQ / 32)) break;
        const int bh = tsk >> 6, qblk = tsk & 63;
        attn_task(F, bh >> 4, bh & 15, qblk, vl);
    }
}
}

typedef float f32x2 __attribute__((ext_vector_type(2)));
__device__ __forceinline__ float dppf(float v, const int ctrl_unused) { return v; }
#define DPP_ADD(v, ctrl) ((v) + __builtin_bit_cast(float, __builtin_amdgcn_update_dpp(0, __builtin_bit_cast(int, (v)), (ctrl), 0xF, 0xF, true)))
__device__ __forceinline__ float row_allsum(float v) {
    v = DPP_ADD(v, 0xB1); v = DPP_ADD(v, 0x4E); v = DPP_ADD(v, 0x124); v = DPP_ADD(v, 0x128); return v;
}
__device__ __forceinline__ void conv_phase(Frame& F, const int dry = 0) {
    const int tid = F.tid, c = 2 * tid, lane = F.lane;
    f32x2 wv[CVK];
#pragma unroll
    for (int k = 0; k < CVK; ++k) wv[k] = *(const GAS f32x2*)(F.conv_w + k * D + c);
    const f32x2 cb = *(const GAS f32x2*)(F.conv_b + c), lg = *(const GAS f32x2*)(F.cln_g + c), lb = *(const GAS f32x2*)(F.cln_b + c);
    LAS float* red = (LAS float*)(F.lds + 69632);
    const int li = lane & 15, R = lane >> 4;
    for (int tile = F.bid; tile < M / 128; tile += F.G) {
        const int t0 = tile * 128;
        const GAS unsigned* Up = (const GAS unsigned*)(F.U + (size_t)t0 * D + c);
        GAS unsigned* Zp = (GAS unsigned*)(F.SZCV + (size_t)t0 * D + c);
        f32x2 ring[32];
        const bool has_hist = (t0 & (SEQ - 1)) != 0;
#pragma unroll
        for (int r = 2; r < 32; ++r) { unsigned w = 0u; if (has_hist) w = Up[(r - 32) * (D / 2)]; ring[r] = (f32x2){bf2f(w & 0xffffu), bf2f(w >> 16)}; }
        ring[0] = (f32x2){0.f, 0.f}; ring[1] = (f32x2){0.f, 0.f};
        unsigned pre[8], zpre[8];
#pragma unroll
        for (int e = 0; e < 8; ++e) { pre[e] = Up[e * (D / 2)]; zpre[e] = Zp[e * (D / 2)]; }
        for (int blk = 0; blk < 4; ++blk) {
#pragma unroll
            for (int g = 0; g < 4; ++g) {
                const int rb = 32 * blk + 8 * g;
                unsigned cur[8], zc[8];
#pragma unroll
                for (int e = 0; e < 8; ++e) { cur[e] = pre[e]; zc[e] = zpre[e]; }
#pragma unroll
                for (int e = 0; e < 8; ++e) { pre[e] = Up[(rb + 8 + e) * (D / 2)]; zpre[e] = Zp[(rb + 8 + e) * (D / 2)]; }
                f32x2 y[8]; float st[16];
#pragma unroll
                for (int e = 0; e < 8; ++e) { const int j = 8 * g + e;
                    ring[j] = (f32x2){bf2f(cur[e] & 0xffffu), bf2f(cur[e] >> 16)};
                    f32x2 a = cb;
#pragma unroll
                    for (int k = 0; k < CVK; ++k) a += wv[k] * ring[(j + 2 + k) & 31];
                    y[e] = a; st[2 * e] = a.x + a.y; st[2 * e + 1] = a.x * a.x + a.y * a.y; }
                float a8[8], b4[4];
#pragma unroll
                for (int i = 0; i < 8; ++i) { const auto rr = __builtin_amdgcn_permlane32_swap(__float_as_uint(st[i]), __float_as_uint(st[i + 8]), false, false); a8[i] = __uint_as_float(rr[0]) + __uint_as_float(rr[1]); }
#pragma unroll
                for (int i = 0; i < 4; ++i) { const auto rr = __builtin_amdgcn_permlane16_swap(__float_as_uint(a8[i]), __float_as_uint(a8[i + 4]), false, false); b4[i] = row_allsum(__uint_as_float(rr[0]) + __uint_as_float(rr[1])); }
                LAS float* rp = red + (g & 1) * 128;
                { const float val = li == 0 ? b4[0] : li == 1 ? b4[1] : li == 2 ? b4[2] : b4[3]; if (li < 4) rp[(4 * R + li) * 8 + F.wave] = val; }
                __syncthreads();
                float tot = 0.f;
                if (lane < 16) { const f32x4 p = *(const LAS f32x4*)(rp + lane * 8), q = *(const LAS f32x4*)(rp + lane * 8 + 4); tot = ((p.x + p.y) + (p.z + p.w)) + ((q.x + q.y) + (q.z + q.w)); }
#pragma unroll
                for (int e = 0; e < 8; ++e) {
                    const float s1 = __builtin_amdgcn_readlane(tot, 2 * e), s2 = __builtin_amdgcn_readlane(tot, 2 * e + 1);
                    const float mean = s1 * (1.f / D), var = fmaxf(s2 * (1.f / D) - mean * mean, 0.f);
                    const float rstd = 1.f / sqrtf(var + LN_EPS);
                    const f32x2 yn = ((y[e] - mean) * rstd) * lg + lb;
                    const unsigned res = pk2(yn.x * pg8::sigmoidf_(yn.x) * bf2f(zc[e] & 0xffffu), yn.y * pg8::sigmoidf_(yn.y) * bf2f(zc[e] >> 16));
                    if (!dry) Zp[(rb + e) * (D / 2)] = res; }
            }
        }
    }
}

__device__ __forceinline__ void lnpost_phase(Frame& F, const int dry = 0) {
    const int gw = F.bid * NWAVES + F.wave, NGW = F.G * NWAVES;
    for (int m = gw; m < M; m += NGW) {
        GAS f32x4* xr = (GAS f32x4*)(F.out + (size_t)m * D) + F.lane;
        f32x4 v[4]; float s = 0.f;
#pragma unroll
        for (int j = 0; j < 4; ++j) { v[j] = xr[64 * j]; s += (v[j].x + v[j].y) + (v[j].z + v[j].w); }
        const float mean = wave_sum(s) * (1.f / D); float s2 = 0.f;
#pragma unroll
        for (int j = 0; j < 4; ++j) { v[j] = v[j] - mean; s2 += (v[j].x * v[j].x + v[j].y * v[j].y) + (v[j].z * v[j].z + v[j].w * v[j].w); }
        const float rstd = 1.f / sqrtf(wave_sum(s2) * (1.f / D) + LN_EPS);
#pragma unroll
        for (int j = 0; j < 4; ++j) { const f32x4 g = *((const GAS f32x4*)F.lnp_g + F.lane + 64 * j), b = *((const GAS f32x4*)F.lnp_b + F.lane + 64 * j); const f32x4 res = (v[j] * rstd) * g + b; if (!dry) xr[64 * j] = res; }
    }
}

#ifndef PROBE_DRY_ALL
#define PROBE_DRY_ALL 1
#endif
struct Args { const float* in[13]; float* out; unsigned char* ws; int ph_lo, ph_hi, fused, dry, li, pad; };
constexpr int NPHASE = 8;
__global__ void __launch_bounds__(NWAVES * 64, 2) fwd_kernel(Args args) {
    extern __shared__ __attribute__((aligned(16))) unsigned char lds[];
    Frame F;
    F.lds = (LAS unsigned char*)lds;
    F.tid = threadIdx.x; F.lane = F.tid & 63; F.wave = __builtin_amdgcn_readfirstlane(F.tid >> 6); F.G = gridDim.x; F.bid = blockIdx.x;
    unsigned char* ws = args.ws;
    F.x = args.in[0]; F.ln_in_g = args.in[1]; F.ln_in_b = args.in[2]; F.w_in = args.in[3]; F.w_sb = args.in[4]; F.conv_w = args.in[5]; F.conv_b = args.in[6];
    F.cln_g = args.in[7]; F.cln_b = args.in[8]; F.w_cv = args.in[9]; F.w_out = args.in[10]; F.lnp_g = args.in[11]; F.lnp_b = args.in[12];
    F.out = args.out; F.stats = (float*)(ws + WS_STATS);
    F.WIN = (bf16*)(ws + WS_WIN); F.WSB = (bf16*)(ws + WS_WSB); F.WCV = (bf16*)(ws + WS_WCV); F.WOUT = (bf16*)(ws + WS_WOUT);
    F.XN = (bf16*)args.out; F.ASB = (bf16*)args.out; F.Q = (bf16*)args.out + (size_t)M * D;
    F.K = (bf16*)(ws + WS_K); F.V = (bf16*)(ws + WS_V); F.SZSB = (bf16*)(ws + WS_SZSB); F.U = (bf16*)(ws + WS_U); F.SZCV = (bf16*)(ws + WS_SZCV);
    F.SGSB = (bf16*)(ws + WS_SGSB); F.SGCV = (bf16*)(ws + WS_SGCV); F.MERGED = (bf16*)(ws + WS_MERGED); F.P = (bf16*)(ws + WS_P);
    const int lo = args.ph_lo, hi = args.ph_hi; const bool fused = args.fused != 0;
    volatile LAS unsigned* bst = (volatile LAS unsigned*)(F.lds + BAR_LDS_OFF);
    if (F.tid < 2) bst[F.tid] = 0u;
    __syncthreads();
    XcdBarrier bar; bar.bar = (unsigned*)(ws + WS_CTL) + CW_BAR + args.li * XCD_BAR_WORDS; bar.x = 0; bar.st = nullptr;
    if (fused) bar = xcd_barrier_post((unsigned*)(ws + WS_CTL) + CW_BAR + args.li * XCD_BAR_WORDS, bst);
#define IN(k) (lo <= (k) && (k) < hi)
#if defined(USE_CG_SYNC)
#define SEAM(k) do { if (fused && IN(k) && IN((k) + 1)) { cg::this_grid().sync(); } } while (0)
#else
#define SEAM(k) do { if (fused && IN(k) && IN((k) + 1)) { xcd_barrier(bar); } } while (0)
#endif

    if (IN(0)) { p0_prologue(F); } SEAM(0);
    if (IN(1)) {
        pg8::Gemm g{F.XN, F.WIN, M, NIN, D}; pg8::StaggerOrder S; S.init2(M, NIN, F.G, F.bid, (F.G == 256) ? ((F.bid >> 3) & 1) : 0);
        pg8::f32x4* part = (pg8::f32x4*)(ws + WS_PART) + (size_t)((F.bid >> 4) * 8 + (F.bid & 7)) * (65536 / 4);
        pg8::EpiIn E{F.Q, F.K, F.V, F.SZSB, F.U, F.SZCV, F.SGSB, F.SGCV, (args.dry & 2) && (PROBE_DRY_ALL || ((F.bid >> 3) & 1))};
        pg8::gemm_phase<pg8::EpiIn, pg8::StaggerOrder, true, true>(F.lds, g, S, E, part);
    } SEAM(1);
    #if defined(ATTN_REF)
    if (IN(2)) { attn_ref_phase(F); }
    if (IN(3)) { conv_phase(F, args.dry & 8); } SEAM(3);
#else
    if (IN(2)) { sba::attn_phase(F); }
    if (IN(3)) { conv_phase(F, args.dry & 8); } SEAM(3);
#endif
    if (IN(4)) {
        pg8::Gemm g{F.ASB, F.WSB, M, D, D}; pg8::StaticOrder S; S.init(M, D, F.G, F.bid);
        pg8::EpiGate E{F.SGSB, F.P};
        pg8::gemm_phase<pg8::EpiGate, pg8::StaticOrder, true, true>(F.lds, g, S, E);
    } SEAM(4);
    if (IN(5)) {
        pg8::Gemm g{F.SZCV, F.WCV, M, D, D}; pg8::StaticOrder S; S.init(M, D, F.G, F.bid);
        pg8::EpiGateAdd E{F.SGCV, F.P, F.MERGED};
        pg8::gemm_phase<pg8::EpiGateAdd, pg8::StaticOrder, true, true>(F.lds, g, S, E);
    } SEAM(5);
    if (IN(6)) {
        pg8::Gemm g{F.MERGED, F.WOUT, M, D, D}; pg8::StaticOrder S; S.init(M, D, F.G, F.bid);
        pg8::EpiOut E{F.x, F.stats, F.ln_in_g, F.ln_in_b, F.out, DN_ALPHA};
        pg8::gemm_phase<pg8::EpiOut, pg8::StaticOrder, true, true>(F.lds, g, S, E);
    } SEAM(6);
    if (IN(7)) { lnpost_phase(F, args.dry & 128); }
#undef IN
#undef SEAM
}

#ifndef MK_N_LAUNCHES
#define MK_N_LAUNCHES 1
#endif
extern "C" void kernel_launch(void* const* d_in, const int* in_sizes, int n_in, void* d_out, int out_size, void* d_ws, size_t ws_size, hipStream_t stream) {
    static int grid = 0;
    if (grid == 0) {
        if (n_in != 13 || in_sizes[0] != M * D || out_size != M * D || ws_size < WS_END) { fprintf(stderr, "kernel_launch: unexpected shapes (n_in %d, in0 %d, out %d, ws %zu); nothing launched\n", n_in, n_in > 0 ? in_sizes[0] : -1, out_size, ws_size); grid = -1; return; }
        int dev = 0, cus = 0, per_cu = 0;
        if (hipGetDevice(&dev) != hipSuccess || hipDeviceGetAttribute(&cus, hipDeviceAttributeMultiprocessorCount, dev) != hipSuccess) { grid = -1; return; }
        if (hipFuncSetAttribute((const void*)fwd_kernel, hipFuncAttributeMaxDynamicSharedMemorySize, LDS_BYTES) != hipSuccess) { fprintf(stderr, "kernel_launch: hipFuncSetAttribute failed\n"); grid = -1; return; }
        if (hipOccupancyMaxActiveBlocksPerMultiprocessor(&per_cu, (const void*)fwd_kernel, NWAVES * 64, LDS_BYTES) != hipSuccess || per_cu < 1) { fprintf(stderr, "kernel_launch: occupancy query says %d blocks per CU\n", per_cu); (void)hipGetLastError(); grid = -1; return; }
        grid = cus * (per_cu < 1 ? 1 : 1);
    }
    if (grid < 0) return;
    if (hipMemsetAsync((char*)d_ws + WS_CTL, 0, CTL_ZERO_BYTES, stream) != hipSuccess) { fprintf(stderr, "kernel_launch: hipMemsetAsync failed\n"); return; }
    Args a{};
    for (int i = 0; i < 13; ++i) a.in[i] = (const float*)d_in[i];
    a.out = (float*)d_out; a.ws = (unsigned char*)d_ws;
#if defined(PROBE_SPLIT)
    for (int li = 0; li < 2; ++li) {
        a.ph_lo = li == 0 ? 0 : PROBE_SPLIT; a.ph_hi = li == 0 ? PROBE_SPLIT + 1 : NPHASE; a.fused = 1; a.li = li;
#if defined(PROBE_DRY)
        a.dry = li == 0 ? (1 << PROBE_SPLIT) : 0;
#endif
        void* kargs[] = {&a};
        hipError_t e = hipLaunchCooperativeKernel((const void*)fwd_kernel, dim3(grid), dim3(NWAVES * 64), kargs, LDS_BYTES, stream);
        if (e != hipSuccess) fprintf(stderr, "kernel_launch: cooperative launch failed: %s (grid %d)\n", hipGetErrorString(e), grid);
    }
#else
    if (MK_N_LAUNCHES == 1) {
        a.ph_lo = 0; a.ph_hi = NPHASE; a.fused = 1;
        void* kargs[] = {&a};
        hipError_t e = hipLaunchCooperativeKernel((const void*)fwd_kernel, dim3(grid), dim3(NWAVES * 64), kargs, LDS_BYTES, stream);
        if (e != hipSuccess) fprintf(stderr, "kernel_launch: cooperative launch failed: %s (grid %d)\n", hipGetErrorString(e), grid);
    } else {
        for (int ph = 0; ph < NPHASE; ++ph) {
            a.ph_lo = ph; a.ph_hi = ph + 1; a.fused = 0;
            hipLaunchKernelGGL(fwd_kernel, dim3(grid), dim3(NWAVES * 64), LDS_BYTES, stream, a);
        }
    }
#endif
}
```

```cpp
#include <hip/hip_runtime.h>
#include <hip/hip_cooperative_groups.h>
#include <cstdio>
#include <cstdint>
namespace cg = cooperative_groups;

namespace pg8 {
#define PG8_LAS __attribute__((address_space(3)))
typedef unsigned short bf16_t;
typedef short bf16x8 __attribute__((ext_vector_type(8)));
typedef float f32x4 __attribute__((ext_vector_type(4)));
typedef unsigned u32x4 __attribute__((ext_vector_type(4)));
constexpr int BM = 256, BK = 64, HALF = 128, HTB = HALF * BK * 2  , STAGE_BYTES = 8 * HTB, NXCD = 8, WGM = 8;

__host__ __device__ __forceinline__ int lds_byte(int r, int c) { const int st = (r >> 4) * 2 + (c >> 5), rr = r & 15, cc = c & 31, ob = rr * 64 + cc * 2; return st * 1024 + (ob ^ (((ob >> 9) & 1) << 5)); }
__host__ __device__ __forceinline__ void stage_rc(int b, int& R, int& C) { const int st = b / 1024, sb = b % 1024, swz = sb ^ (((sb >> 9) & 1) << 5); R = (st >> 1) * 16 + swz / 64; C = (st & 1) * 32 + (swz % 64) / 2; }
__host__ __device__ __forceinline__ int perm32(int rho) { const int n = rho >> 4, i = rho & 15; return 8 * (i >> 2) + 4 * n + (i & 3); }

struct Unit { int pm, pn, kt0, nkt, mode; };
struct Gemm { const bf16_t* A; const bf16_t* Bt; int M, N, K; };

struct StaticOrder {
    int nM, nN, nwg, G, c, nkt;
    __host__ __device__ void init(int M, int N, int G_, int c_, int K = 1024) { nM = M / BM; nN = N / BM; nwg = nM * nN; G = G_; c = c_; nkt = K / BK; }
    __host__ __device__ bool next(int i, Unit& u) const {
        const long L = (long)i * G + c; if (L >= nwg) return false;
        int wgid = (int)L; { const int q = nwg / NXCD, r = nwg % NXCD, xcd = wgid % NXCD, off = wgid / NXCD; wgid = (xcd < r ? xcd * (q + 1) : r * (q + 1) + (xcd - r) * q) + off; }
        const int nig = WGM * nN, gid = wgid / nig, fm = gid * WGM, gsz = (nM - fm) < WGM ? (nM - fm) : WGM;
        u.pm = fm + ((wgid % nig) % gsz); u.pn = (wgid % nig) / gsz; u.kt0 = 0; u.nkt = nkt; u.mode = 0; return true;
    }
    __device__ __forceinline__ void a_ready(const Unit&) const {}
    __device__ __forceinline__ void done(const Unit&) const {}
};

struct StaggerOrder : StaticOrder {
    int stag, n;
    __host__ __device__ void init2(int M, int N, int G_, int c_, int stag_, int K = 1024) { init(M, N, G_, c_, K); stag = stag_; n = (nwg - c + G - 1) / G; if (n < 2 || (nkt & 3)) stag = 0; }
    __host__ __device__ bool next(int i, Unit& u) const {
        if (!stag) return StaticOrder::next(i, u);
        if (i > n) return false;
        if (i == 0) { StaticOrder::next(0, u); u.nkt = nkt / 2; u.mode = 1; return true; }
        if (i == n) { StaticOrder::next(0, u); u.kt0 = nkt / 2; u.nkt = nkt / 2; u.mode = 2; return true; }
        return StaticOrder::next(i, u);
    }
};

#ifndef USE_F16
#define USE_F16 0
#endif
typedef _Float16 h16x2 __attribute__((ext_vector_type(2)));
typedef _Float16 h16x8 __attribute__((ext_vector_type(8)));
typedef float f32x2p __attribute__((ext_vector_type(2)));
#if USE_F16
__device__ __forceinline__ unsigned cvt_pk_bf16(float lo, float hi) { const f32x2p v = {lo, hi}; return __builtin_bit_cast(unsigned, __builtin_convertvector(v, h16x2)); }
__device__ __forceinline__ float bflo(unsigned w) { return (float)__builtin_bit_cast(h16x2, w)[0]; }
__device__ __forceinline__ float bfhi(unsigned w) { return (float)__builtin_bit_cast(h16x2, w)[1]; }
__device__ __forceinline__ f32x4 mfma16(bf16x8 a, bf16x8 b, f32x4 c) { return __builtin_amdgcn_mfma_f32_16x16x32_f16(__builtin_bit_cast(h16x8, a), __builtin_bit_cast(h16x8, b), c, 0, 0, 0); }
#else
__device__ __forceinline__ unsigned cvt_pk_bf16(float lo, float hi) { unsigned r; asm volatile("v_cvt_pk_bf16_f32 %0, %1, %2" : "=v"(r) : "v"(lo), "v"(hi)); return r; }
__device__ __forceinline__ float bflo(unsigned w) { return __uint_as_float(w << 16); }
__device__ __forceinline__ float bfhi(unsigned w) { return __uint_as_float(w & 0xffff0000u); }
__device__ __forceinline__ f32x4 mfma16(bf16x8 a, bf16x8 b, f32x4 c) { return __builtin_amdgcn_mfma_f32_16x16x32_bf16(a, b, c, 0, 0, 0); }
#endif
__device__ __forceinline__ float sigmoidf_(float x) { return __builtin_amdgcn_rcpf(1.0f + __builtin_amdgcn_exp2f(-1.4426950408889634f * x)); }
__device__ __forceinline__ f32x4 sig4(f32x4 v) { return (f32x4){sigmoidf_(v[0]), sigmoidf_(v[1]), sigmoidf_(v[2]), sigmoidf_(v[3])}; }
__device__ __forceinline__ u32x4 pack8(f32x4 v0, f32x4 v1) { u32x4 w; w.x = cvt_pk_bf16(v0[0], v0[1]); w.y = cvt_pk_bf16(v0[2], v0[3]); w.z = cvt_pk_bf16(v1[0], v1[1]); w.w = cvt_pk_bf16(v1[2], v1[3]); return w; }
__device__ __forceinline__ void unpack8(u32x4 w, f32x4& v0, f32x4& v1) { v0 = (f32x4){bflo(w.x), bfhi(w.x), bflo(w.y), bfhi(w.y)}; v1 = (f32x4){bflo(w.z), bfhi(w.z), bflo(w.w), bfhi(w.w)}; }

constexpr float QSCALE = 0.125f * 1.4426950408889634f;

struct EpiIn {
    static constexpr bool PERM = true, AFTER_DRAIN = false;
    bf16_t *Q, *Kb, *Vb, *SZSB, *U, *SZCV, *SGSB, *SGCV; int dry;
    __device__ __forceinline__ void operator()(const f32x4 (&acc)[2][2][4][2], const Unit& u, int wr, int wc, int fr, int fq) const {
        const int row0 = u.pm * BM + wr * 64 + fr; const int pn = u.pn;
        if (pn >= 16 && pn < 24) {
            bf16_t* base = U + (pn - 16) * 128 + wc * 32 + 8 * fq;
#pragma unroll
            for (int ai = 0; ai < 2; ++ai)
#pragma unroll
                for (int m = 0; m < 4; ++m) { bf16_t* rowp = base + (size_t)(row0 + ai * HALF + m * 16) * 1024;
                    const f32x4 v0 = acc[ai][0][m][0] * sig4(acc[ai][1][m][0]), v1 = acc[ai][0][m][1] * sig4(acc[ai][1][m][1]);
                    const u32x4 pk = pack8(v0, v1); if (!dry) *(u32x4*)rowp = pk; }
            return;
        }
        const int grp = pn >> 2; int mode; bf16_t* base;
        float sc = 1.f;
        if (grp == 0) { base = Q; mode = 0; sc = QSCALE; } else if (grp == 1) { base = Kb; mode = 0; } else if (grp == 2) { base = Vb; mode = 0; }
        else if (grp == 3) { base = SZSB; mode = 1; } else if (grp == 6) { base = SZCV; mode = 1; } else if (grp == 7) { base = SGSB; mode = 2; } else { base = SGCV; mode = 2; }
        base += (pn & 3) * BM + wc * 32 + 8 * fq;
#pragma unroll
        for (int ai = 0; ai < 2; ++ai)
#pragma unroll
            for (int m = 0; m < 4; ++m) { bf16_t* rowp = base + (size_t)(row0 + ai * HALF + m * 16) * 1024;
#pragma unroll
                for (int bj = 0; bj < 2; ++bj) { f32x4 v0 = acc[ai][bj][m][0], v1 = acc[ai][bj][m][1];
                    if (mode == 0) { v0 = v0 * sc; v1 = v1 * sc; }
                    else if (mode == 1) { v0 = v0 * sig4(v0); v1 = v1 * sig4(v1); }
                    else { v0 = sig4(v0); v1 = sig4(v1); }
                    const u32x4 pk = pack8(v0, v1); if (!dry) *(u32x4*)(rowp + bj * HALF) = pk; } }
    }
};
struct EpiGate {
    static constexpr bool PERM = true, AFTER_DRAIN = false;
    const bf16_t* G; bf16_t* P;
    __device__ __forceinline__ void operator()(const f32x4 (&acc)[2][2][4][2], const Unit& u, int wr, int wc, int fr, int fq) const {
        const int row0 = u.pm * BM + wr * 64 + fr, col0 = u.pn * BM + wc * 32 + 8 * fq;
#pragma unroll
        for (int ai = 0; ai < 2; ++ai)
#pragma unroll
            for (int m = 0; m < 4; ++m) { const size_t off = (size_t)(row0 + ai * HALF + m * 16) * 1024 + col0;
#pragma unroll
                for (int bj = 0; bj < 2; ++bj) { f32x4 g0, g1; unpack8(*(const u32x4*)(G + off + bj * HALF), g0, g1);
                    *(u32x4*)(P + off + bj * HALF) = pack8(acc[ai][bj][m][0] * g0, acc[ai][bj][m][1] * g1); } }
    }
};
struct EpiGateAdd {
    static constexpr bool PERM = true, AFTER_DRAIN = false;
    const bf16_t* G; const bf16_t* P; bf16_t* O;
    __device__ __forceinline__ void operator()(const f32x4 (&acc)[2][2][4][2], const Unit& u, int wr, int wc, int fr, int fq) const {
        const int row0 = u.pm * BM + wr * 64 + fr, col0 = u.pn * BM + wc * 32 + 8 * fq;
#pragma unroll
        for (int ai = 0; ai < 2; ++ai)
#pragma unroll
            for (int m = 0; m < 4; ++m) { const size_t off = (size_t)(row0 + ai * HALF + m * 16) * 1024 + col0;
#pragma unroll
                for (int bj = 0; bj < 2; ++bj) { f32x4 g0, g1, p0, p1; unpack8(*(const u32x4*)(G + off + bj * HALF), g0, g1); unpack8(*(const u32x4*)(P + off + bj * HALF), p0, p1);
                    *(u32x4*)(O + off + bj * HALF) = pack8(p0 + acc[ai][bj][m][0] * g0, p1 + acc[ai][bj][m][1] * g1); } }
    }
};
struct EpiOut {
    static constexpr bool PERM = false, AFTER_DRAIN = false;
    const float* x; const float* stats; const float* g; const float* b; float* C; float alpha;
    __device__ __forceinline__ void operator()(const f32x4 (&acc)[2][2][4][2], const Unit& u, int wr, int wc, int fr, int fq) const {
        const int row0 = u.pm * BM + wr * 64 + fr, col0 = u.pn * BM + wc * 32 + 4 * fq;
        f32x4 gv[2][2], bv[2][2];
#pragma unroll
        for (int bj = 0; bj < 2; ++bj)
#pragma unroll
            for (int n = 0; n < 2; ++n) { gv[bj][n] = *(const f32x4*)(g + col0 + bj * HALF + n * 16) * alpha; bv[bj][n] = *(const f32x4*)(b + col0 + bj * HALF + n * 16) * alpha; }
#pragma unroll
        for (int ai = 0; ai < 2; ++ai)
#pragma unroll
            for (int m = 0; m < 4; ++m) { const int row = row0 + ai * HALF + m * 16; const size_t off = (size_t)row * 1024 + col0;
                const float mu = stats[2 * row], rs = stats[2 * row + 1];
#pragma unroll
                for (int bj = 0; bj < 2; ++bj)
#pragma unroll
                    for (int n = 0; n < 2; ++n) { const f32x4 xv = *(const f32x4*)(x + off + bj * HALF + n * 16);
                        *(f32x4*)(C + off + bj * HALF + n * 16) = ((xv - mu) * rs) * gv[bj][n] + bv[bj][n] + acc[ai][bj][m][n]; } }
    }
};

template <class Epi, class Sched, bool ALIGN_EPI = false, bool SP2 = false>
__device__ __forceinline__ void gemm_phase(PG8_LAS unsigned char* lds, const Gemm g, const Sched& S, const Epi& E, f32x4* part = nullptr) {
    const int tid = threadIdx.x, wid = __builtin_amdgcn_readfirstlane(tid >> 6), lane = tid & 63, wr = wid >> 2, wc = wid & 3, fr = lane & 15, fq = lane >> 4;
    const int K = g.K;
    unsigned voffA[2], voffB[2];
#pragma unroll
    for (int i = 0; i < 2; ++i) { int R, C; stage_rc(tid * 16 + i * 8192, R, C); const int Rb = Epi::PERM ? ((R & ~31) + perm32(R & 31)) : R;
        voffA[i] = (unsigned)(R * K + C) * 2u; voffB[i] = (unsigned)(Rb * K + C) * 2u; }
    const size_t kstep = (size_t)(BK * 2);
    const size_t hstep = (size_t)HALF * K * 2;
    const size_t tstep = 2 * hstep;
    const unsigned ldsw = (unsigned)wid * 1024u;
    const int aoff = lds_byte(wr * 64 + fr, fq * 8), boff = lds_byte(wc * 32 + fr, fq * 8);
#define PG8_SA(b, h) (((b) * 2 + (h)) * HTB)
#define PG8_SB(b, h) ((4 + (b) * 2 + (h)) * HTB)
#define PG8_STAGE(bufoff, gbase, voff) do { _Pragma("unroll") for (int _i = 0; _i < 2; ++_i) \
        __builtin_amdgcn_global_load_lds((const unsigned*)((const char*)(gbase) + (voff)[_i]), (PG8_LAS unsigned*)(lds + (bufoff) + ldsw + _i * 8192), 16, 0, 0); } while (0)
#define PG8_LDA(dst, b, h) do { _Pragma("unroll") for (int m = 0; m < 4; ++m) _Pragma("unroll") for (int k = 0; k < 2; ++k) dst[m][k] = *(const PG8_LAS bf16x8*)(lds + PG8_SA(b, h) + aoff + m * 2048 + k * 1024); } while (0)
#define PG8_LDB(dst, b, h) do { _Pragma("unroll") for (int n = 0; n < 2; ++n) _Pragma("unroll") for (int k = 0; k < 2; ++k) dst[n][k] = *(const PG8_LAS bf16x8*)(lds + PG8_SB(b, h) + boff + n * 2048 + k * 1024); } while (0)
#define PG8_MMA(ai, bj, At, Bt) do { __builtin_amdgcn_s_setprio(1); _Pragma("unroll") for (int m = 0; m < 4; ++m) _Pragma("unroll") for (int n = 0; n < 2; ++n) _Pragma("unroll") for (int k = 0; k < 2; ++k) \
        acc[ai][bj][m][n] = mfma16(Bt[n][k], At[m][k], acc[ai][bj][m][n]); __builtin_amdgcn_s_setprio(0); } while (0)
#define PG8_WAIT_V(n) asm volatile("s_waitcnt vmcnt(" #n ")" ::: "memory")
#define PG8_WAIT_L(n) asm volatile("s_waitcnt lgkmcnt(" #n ")" ::: "memory")
#define PG8_BAR __builtin_amdgcn_s_barrier()
#define PG8_SCHED __builtin_amdgcn_sched_barrier(0)
    Unit cur, nxt; int ui = 0;
    if (!S.next(0, cur)) return;
    f32x4 acc[2][2][4][2];
#pragma unroll
    for (int a = 0; a < 2; ++a)
#pragma unroll
        for (int b = 0; b < 2; ++b)
#pragma unroll
            for (int m = 0; m < 4; ++m)
#pragma unroll
                for (int n = 0; n < 2; ++n) acc[a][b][m][n] = (f32x4){0.f, 0.f, 0.f, 0.f};
    bf16x8 At[4][2], B0[2][2], B1[2][2];
    const char* cA = (const char*)g.A + (size_t)cur.pm * tstep + (size_t)cur.kt0 * (BK * 2); const char* cB = (const char*)g.Bt + (size_t)cur.pn * tstep + (size_t)cur.kt0 * (BK * 2);
    S.a_ready(cur);
    if constexpr (SP2) {
        PG8_STAGE(PG8_SB(0, 0), cB, voffB); PG8_STAGE(PG8_SB(0, 1), cB + hstep, voffB); PG8_STAGE(PG8_SA(0, 0), cA, voffA); PG8_STAGE(PG8_SA(0, 1), cA + hstep, voffA);
        if (wr == 1) PG8_BAR;
        PG8_WAIT_V(2); PG8_BAR;
        PG8_STAGE(PG8_SB(1, 0), cB + kstep, voffB); PG8_STAGE(PG8_SA(1, 0), cA + kstep, voffA); PG8_STAGE(PG8_SB(1, 1), cB + hstep + kstep, voffB);
        PG8_WAIT_V(6); PG8_BAR;
    } else {
        PG8_STAGE(PG8_SB(0, 0), cB, voffB); PG8_STAGE(PG8_SA(0, 0), cA, voffA); PG8_STAGE(PG8_SB(0, 1), cB + hstep, voffB); PG8_STAGE(PG8_SA(0, 1), cA + hstep, voffA);
        if (wr == 1) PG8_BAR;
        PG8_WAIT_V(4); PG8_BAR;
        PG8_STAGE(PG8_SB(1, 0), cB + kstep, voffB); PG8_STAGE(PG8_SA(1, 0), cA + kstep, voffA); PG8_STAGE(PG8_SB(1, 1), cB + hstep + kstep, voffB);
        PG8_WAIT_V(6); PG8_BAR;
    }
    for (;;) {
        const bool has_next = S.next(ui + 1, nxt);
        const char* nA = has_next ? (const char*)g.A + (size_t)nxt.pm * tstep + (size_t)nxt.kt0 * (BK * 2) : cA; const char* nB = has_next ? (const char*)g.Bt + (size_t)nxt.pn * tstep + (size_t)nxt.kt0 * (BK * 2) : cB;
        const int nt = cur.nkt;
        for (int t = 0; t < nt; t += 2) {
            const bool last = (t == nt - 2);
            const char* a1 = cA + (size_t)(t + 1) * kstep;
            const char* a2 = last ? nA : cA + (size_t)(t + 2) * kstep; const char* b2 = last ? nB : cB + (size_t)(t + 2) * kstep;
            const char* a3 = a2 + kstep; const char* b3 = b2 + kstep;
            if (last && has_next) S.a_ready(nxt);
            if constexpr (SP2) {
            PG8_LDB(B0, 0, 0); PG8_LDB(B1, 0, 1); PG8_SCHED; PG8_LDA(At, 0, 0); PG8_STAGE(PG8_SA(1, 1), a1 + hstep, voffA);
            PG8_WAIT_V(8); PG8_WAIT_L(0); PG8_BAR; PG8_MMA(0, 0, At, B0); PG8_MMA(0, 1, At, B1); PG8_BAR; PG8_SCHED;
            PG8_LDA(At, 0, 1); PG8_STAGE(PG8_SB(0, 0), b2, voffB); PG8_STAGE(PG8_SB(0, 1), b2 + hstep, voffB); PG8_STAGE(PG8_SA(0, 0), a2, voffA);
            PG8_WAIT_V(8); PG8_WAIT_L(0); PG8_BAR; PG8_MMA(1, 0, At, B0); PG8_MMA(1, 1, At, B1); PG8_BAR; PG8_SCHED;
            PG8_LDB(B0, 1, 0); PG8_LDB(B1, 1, 1); PG8_SCHED; PG8_LDA(At, 1, 0); PG8_STAGE(PG8_SA(0, 1), a2 + hstep, voffA);
            PG8_WAIT_V(8); PG8_WAIT_L(0); PG8_BAR; PG8_MMA(0, 0, At, B0); PG8_MMA(0, 1, At, B1); PG8_BAR; PG8_SCHED;
            PG8_LDA(At, 1, 1); PG8_STAGE(PG8_SB(1, 0), b3, voffB); PG8_STAGE(PG8_SB(1, 1), b3 + hstep, voffB); PG8_STAGE(PG8_SA(1, 0), a3, voffA);
            PG8_WAIT_V(8); PG8_WAIT_L(0); PG8_BAR; PG8_MMA(1, 0, At, B0); PG8_MMA(1, 1, At, B1); PG8_BAR; PG8_SCHED;
            } else {
            PG8_LDB(B0, 0, 0); PG8_SCHED; PG8_LDA(At, 0, 0); PG8_STAGE(PG8_SA(1, 1), a1 + hstep, voffA);
            PG8_WAIT_L(8); PG8_BAR; PG8_WAIT_L(0); PG8_MMA(0, 0, At, B0); PG8_BAR; PG8_SCHED;
            PG8_LDB(B1, 0, 1); PG8_STAGE(PG8_SB(0, 0), b2, voffB);
            PG8_BAR; PG8_WAIT_L(0); PG8_MMA(0, 1, At, B1); PG8_BAR;
            PG8_LDA(At, 0, 1); PG8_STAGE(PG8_SA(0, 0), a2, voffA);
            PG8_BAR; PG8_WAIT_L(0); PG8_MMA(1, 0, At, B0); PG8_BAR; PG8_SCHED;
            PG8_STAGE(PG8_SB(0, 1), b2 + hstep, voffB);
            PG8_WAIT_V(6); PG8_BAR; PG8_MMA(1, 1, At, B1); PG8_BAR;
            PG8_LDB(B0, 1, 0); PG8_SCHED; PG8_LDA(At, 1, 0); PG8_STAGE(PG8_SA(0, 1), a2 + hstep, voffA);
            PG8_WAIT_L(8); PG8_BAR; PG8_WAIT_L(0); PG8_MMA(0, 0, At, B0); PG8_BAR; PG8_SCHED;
            PG8_LDB(B1, 1, 1); PG8_STAGE(PG8_SB(1, 0), b3, voffB);
            PG8_BAR; PG8_WAIT_L(0); PG8_MMA(0, 1, At, B1); PG8_BAR;
            PG8_LDA(At, 1, 1); PG8_STAGE(PG8_SA(1, 0), a3, voffA);
            PG8_BAR; PG8_WAIT_L(0); PG8_MMA(1, 0, At, B0); PG8_BAR; PG8_SCHED;
            PG8_STAGE(PG8_SB(1, 1), b3 + hstep, voffB);
            PG8_WAIT_V(6); PG8_BAR; PG8_MMA(1, 1, At, B1); PG8_BAR;
            }
        }
        if constexpr (ALIGN_EPI) { if (wr == 0) PG8_BAR; }
        if (cur.mode == 1) {
            __attribute__((address_space(1))) f32x4* pp = (__attribute__((address_space(1))) f32x4*)part + tid;
#pragma unroll
            for (int a = 0; a < 2; ++a)
#pragma unroll
                for (int b = 0; b < 2; ++b)
#pragma unroll
                    for (int m = 0; m < 4; ++m)
#pragma unroll
                        for (int n = 0; n < 2; ++n) { *pp = acc[a][b][m][n]; pp += 512; asm volatile("" : "+v"(pp)); }
        } else
        if constexpr (!Epi::AFTER_DRAIN) { E(acc, cur, wr, wc, fr, fq); S.done(cur); }
        if (!has_next) break;
        if (nxt.mode == 2) {
            const __attribute__((address_space(1))) f32x4* pp = (const __attribute__((address_space(1))) f32x4*)part + tid;
#pragma unroll
            for (int a = 0; a < 2; ++a)
#pragma unroll
                for (int b = 0; b < 2; ++b)
#pragma unroll
                    for (int m = 0; m < 4; ++m)
#pragma unroll
                        for (int n = 0; n < 2; ++n) { acc[a][b][m][n] = *pp; pp += 512; asm volatile("" : "+v"(pp)); }
        } else {
#pragma unroll
        for (int a = 0; a < 2; ++a)
#pragma unroll
            for (int b = 0; b < 2; ++b)
#pragma unroll
                for (int m = 0; m < 4; ++m)
#pragma unroll
                    for (int n = 0; n < 2; ++n) acc[a][b][m][n] = (f32x4){0.f, 0.f, 0.f, 0.f};
        }
        cur = nxt; cA = nA; cB = nB; ++ui;
        if constexpr (ALIGN_EPI) { if (wr == 1) PG8_BAR; }
    }
    PG8_WAIT_V(0);
    if constexpr (!ALIGN_EPI) { if (wr == 0) PG8_BAR; }
    PG8_BAR;
    if constexpr (Epi::AFTER_DRAIN) { E.fused(acc, cur, wr, wc, fr, fq, lds, wid, lane); S.done(cur); }
#undef PG8_SA
#undef PG8_SB
#undef PG8_STAGE
#undef PG8_LDA
#undef PG8_LDB
#undef PG8_MMA
#undef PG8_WAIT_V
#undef PG8_WAIT_L
#undef PG8_BAR
#undef PG8_SCHED
}
}

constexpr int NWAVES = 8;
constexpr int NB = 16, SEQ = 2048, D = 1024, NH = 16, HD = 64, NIN = 9216, CVK = 31;
constexpr int M = NB * SEQ;
constexpr float LN_EPS = 1e-5f;
constexpr float DN_ALPHA = 1.189207115002721f;

constexpr size_t MiB = 1u << 20;
constexpr size_t WS_CTL = 0;
constexpr size_t WS_STATS = 1 * MiB;
constexpr size_t WS_WIN = 2 * MiB;
constexpr size_t WS_WSB = 20 * MiB, WS_WCV = 22 * MiB, WS_WOUT = 24 * MiB;
constexpr size_t WS_K = 32 * MiB, WS_V = 96 * MiB, WS_SZSB = 160 * MiB, WS_U = 224 * MiB, WS_SZCV = 288 * MiB, WS_SGSB = 352 * MiB, WS_SGCV = 416 * MiB, WS_PART = 480 * MiB, WS_END = 512 * MiB;
constexpr size_t WS_MERGED = WS_K;
constexpr size_t WS_P = WS_V;

constexpr int LDS_BYTES = 147456;
constexpr int BAR_LDS_OFF = 139264;
constexpr int CW_BAR = 4096;
constexpr size_t CTL_ZERO_BYTES = 65536;

#define GAS __attribute__((address_space(1)))
#define LAS __attribute__((address_space(3)))
typedef unsigned short bf16;
typedef unsigned v4u __attribute__((ext_vector_type(4)));
typedef float f32x4 __attribute__((ext_vector_type(4)));
#define LDS_WAIT() asm volatile("s_waitcnt lgkmcnt(0)" ::: "memory")
__device__ __forceinline__ unsigned pk2(float lo, float hi) { return pg8::cvt_pk_bf16(lo, hi); }
__device__ __forceinline__ unsigned f2bf(float f) { return pk2(f, 0.f) & 0xffffu; }
__device__ __forceinline__ float bf2f(unsigned b) { return pg8::bflo(b); }

struct Frame {
    LAS unsigned char* lds;
    int tid, lane, wave, G, bid;
    const float *x, *ln_in_g, *ln_in_b, *w_in, *w_sb, *conv_w, *conv_b, *cln_g, *cln_b, *w_cv, *w_out, *lnp_g, *lnp_b;
    float* out; float* stats;
    bf16 *WIN, *WSB, *WCV, *WOUT, *XN, *ASB, *Q, *K, *V, *SZSB, *U, *SZCV, *SGSB, *SGCV, *MERGED, *P;
};

__device__ __forceinline__ float wave_sum(float v) {
#pragma unroll
    for (int o = 1; o < 64; o <<= 1) v += __shfl_xor(v, o);
    return v;
}
#define XB_TMO      128
#define XB_XCNT(j)  (256  + 64 * (j))
#define XB_XSUB(j)  (1280 + 64 * (j))
#define XB_XGEN(j)  (2304 + 64 * (j))
#define XB_TOP      3328
#define XB_TOPGEN   3392
#define XCD_BAR_WORDS 3456
#define XB_SPIN_CAP (1u << 18)

__device__ __forceinline__ unsigned xb_ld(unsigned* p)              { return __hip_atomic_load(p, __ATOMIC_RELAXED, __HIP_MEMORY_SCOPE_AGENT); }
__device__ __forceinline__ unsigned xb_add(unsigned* p, unsigned v) { return __hip_atomic_fetch_add(p, v, __ATOMIC_RELAXED, __HIP_MEMORY_SCOPE_AGENT); }
__device__ __forceinline__ unsigned xb_xcc_id() { return (unsigned)__builtin_amdgcn_s_getreg((3 << 11) | 20) & 0xFu; }
#define XB_SPIN(cond, bar) do { unsigned _sp = 0; while (cond) { __builtin_amdgcn_s_sleep(1); \
    if ((++_sp & 255u) == 0u) { if (xb_ld(&(bar)[XB_TMO])) break; if (_sp > XB_SPIN_CAP) { atomicAdd(&(bar)[XB_TMO], 1u); break; } } } } while (0)

struct XcdBarrier {
    unsigned* bar; unsigned x;
    volatile LAS unsigned* st;
};

__device__ __forceinline__ XcdBarrier xcd_barrier_post(unsigned* bar, volatile LAS unsigned* st) {
    XcdBarrier b; b.bar = bar; b.x = xb_xcc_id(); b.st = st;
    if (threadIdx.x == 0) (void)xb_add(&bar[XB_XCNT(b.x)], 1u);
    return b;
}
__device__ __forceinline__ void xcd_barrier_complete(unsigned* bar, unsigned x, unsigned& nloc, unsigned& nx) {
    const unsigned G = gridDim.x * gridDim.y * gridDim.z;
    unsigned sum, cnt, mine, sp = 0u;
    for (;;) {
        sum = 0u; cnt = 0u; mine = 0u;
#pragma unroll
        for (unsigned j = 0; j < 16; ++j) { const unsigned c = xb_ld(&bar[XB_XCNT(j)]); sum += c; cnt += (c > 0u) ? 1u : 0u; mine = (j == x) ? c : mine; }
        if (sum == G) break;
        __builtin_amdgcn_s_sleep(1);
        if ((++sp & 255u) == 0u) { if (xb_ld(&bar[XB_TMO])) break; if (sp > XB_SPIN_CAP) { atomicAdd(&bar[XB_TMO], 1u); break; } }
    }
    nloc = mine > 0u ? mine : 1u; nx = cnt > 0u ? cnt : 1u;
}

__device__ __forceinline__ void xcd_barrier(const XcdBarrier& b) {
    asm volatile("s_waitcnt vmcnt(0)" ::: "memory");
    __syncthreads();
    if (threadIdx.x == 0) {
        unsigned* bar = b.bar;
        __builtin_amdgcn_s_waitcnt(0);
        unsigned nloc = b.st[0], nx = b.st[1];
        if (nloc == 0u) { xcd_barrier_complete(bar, b.x, nloc, nx); b.st[0] = nloc; b.st[1] = nx; }
        const unsigned old = xb_add(&bar[XB_XSUB(b.x)], 1u);
        const unsigned gen = old / nloc;
        if (old + 1u == (gen + 1u) * nloc) {
            __builtin_amdgcn_fence(__ATOMIC_RELEASE, "agent");
            asm volatile("s_waitcnt vmcnt(0)" ::: "memory");
            const unsigned og = xb_add(&bar[XB_TOP], 1u);
            const unsigned tg = og / nx;
            if (og + 1u == (tg + 1u) * nx) xb_add(&bar[XB_TOPGEN], 1u);
            else XB_SPIN(xb_ld(&bar[XB_TOPGEN]) == tg, bar);
            __builtin_amdgcn_fence(__ATOMIC_ACQUIRE, "agent");
            xb_add(&bar[XB_XGEN(b.x)], 1u);
            asm volatile("s_waitcnt vmcnt(0)" ::: "memory");
        } else {
            XB_SPIN(xb_ld(&bar[XB_XGEN(b.x)]) == gen, bar);
            __builtin_amdgcn_fence(__ATOMIC_ACQUIRE, "agent");
            asm volatile("s_waitcnt vmcnt(0)" ::: "memory");
        }
    }
    __syncthreads();
}

__device__ __forceinline__ void p0_transpose_item(const float* W, int K, int N, bf16* WT, int dst_row0, int src_col0, int kb, LAS float* scr, int lane) {
    const int k0 = 64 * kb;
#pragma unroll 8
    for (int i = 0; i < 32; ++i) { const int kk = 2 * i + (lane >> 5); scr[kk * 33 + (lane & 31)] = W[(size_t)(k0 + kk) * N + src_col0 + (lane & 31)]; }
    LDS_WAIT(); asm volatile("" ::: "memory");
    const int c = lane & 7;
#pragma unroll
    for (int j = 0; j < 4; ++j) { const int n = (lane >> 3) + 8 * j; const LAS float* s = scr + (8 * c) * 33 + n;
        v4u o; o.x = pk2(s[0 * 33], s[1 * 33]); o.y = pk2(s[2 * 33], s[3 * 33]); o.z = pk2(s[4 * 33], s[5 * 33]); o.w = pk2(s[6 * 33], s[7 * 33]);
        *(GAS v4u*)(WT + (size_t)(dst_row0 + n) * K + k0 + 8 * c) = o; }
    LDS_WAIT(); asm volatile("" ::: "memory");
}
__device__ __forceinline__ int win_src_col(int n) {
    if (n < 4096 || n >= 6144) return n;
    const int r = n - 4096, j = r >> 8, q = r & 255;
    return q < 128 ? 4096 + 128 * j + q : 5120 + 128 * j + (q - 128);
}
__device__ __forceinline__ void p0_prologue(Frame& F) {
    LAS float* scr = (LAS float*)(F.lds + F.wave * 16384);
    const int gw = F.bid * NWAVES + F.wave, NGW = F.G * NWAVES;
    constexpr int I_IN = (D / 64) * (NIN / 32), I_SQ = (D / 64) * (D / 32);
    for (int it = gw; it < I_IN + 3 * I_SQ; it += NGW) {
        int r = it;
        if (r < I_IN) { const int kb = r / (NIN / 32), nb = r % (NIN / 32); p0_transpose_item(F.w_in, D, NIN, F.WIN, 32 * nb, win_src_col(32 * nb), kb, scr, F.lane); continue; } r -= I_IN;
        if (r < I_SQ) { p0_transpose_item(F.w_sb, D, D, F.WSB, 32 * (r % (D / 32)), 32 * (r % (D / 32)), r / (D / 32), scr, F.lane); continue; } r -= I_SQ;
        if (r < I_SQ) { p0_transpose_item(F.w_cv, D, D, F.WCV, 32 * (r % (D / 32)), 32 * (r % (D / 32)), r / (D / 32), scr, F.lane); continue; } r -= I_SQ;
        p0_transpose_item(F.w_out, D, D, F.WOUT, 32 * (r % (D / 32)), 32 * (r % (D / 32)), r / (D / 32), scr, F.lane);
    }
    for (int m = gw; m < M; m += NGW) {
        const GAS f32x4* xr = (const GAS f32x4*)(F.x + (size_t)m * D) + F.lane;
        f32x4 v[4]; float s = 0.f;
#pragma unroll
        for (int j = 0; j < 4; ++j) { v[j] = xr[64 * j]; s += (v[j].x + v[j].y) + (v[j].z + v[j].w); }
        const float mean = wave_sum(s) * (1.f / D); float s2 = 0.f;
#pragma unroll
        for (int j = 0; j < 4; ++j) { const f32x4 d = v[j] - mean; s2 += (d.x * d.x + d.y * d.y) + (d.z * d.z + d.w * d.w); }
        const float rstd = 1.f / sqrtf(wave_sum(s2) * (1.f / D) + LN_EPS);
        if (F.lane == 0) { F.stats[2 * m] = mean; F.stats[2 * m + 1] = rstd; }
        GAS unsigned long long* o8 = (GAS unsigned long long*)(F.XN + (size_t)m * D) + F.lane;
#pragma unroll
        for (int j = 0; j < 4; ++j) { const f32x4 g = *((const GAS f32x4*)F.ln_in_g + F.lane + 64 * j), b = *((const GAS f32x4*)F.ln_in_b + F.lane + 64 * j);
            const f32x4 y = ((v[j] - mean) * rstd) * g + b;
            o8[64 * j] = (unsigned long long)pk2(y.x, y.y) | ((unsigned long long)pk2(y.z, y.w) << 32); }
    }
}

__device__ __forceinline__ void attn_ref_task(Frame& F, int row, int h) {
    const int lane = F.lane; const int t = row & (SEQ - 1); const int rowb = row - t;
    float qd[64];
    { const GAS v4u* qp = (const GAS v4u*)(F.Q + (size_t)row * D + h * HD);
#pragma unroll
      for (int i = 0; i < 8; ++i) { const v4u w = qp[i]; qd[8 * i + 0] = bf2f(w.x & 0xffffu); qd[8 * i + 1] = bf2f(w.x >> 16); qd[8 * i + 2] = bf2f(w.y & 0xffffu); qd[8 * i + 3] = bf2f(w.y >> 16);
          qd[8 * i + 4] = bf2f(w.z & 0xffffu); qd[8 * i + 5] = bf2f(w.z >> 16); qd[8 * i + 6] = bf2f(w.w & 0xffffu); qd[8 * i + 7] = bf2f(w.w >> 16); } }
    float o = 0.f, carry = 0.f;
    for (int j = (t - 1) >> 6; j >= 0; --j) {
        const int s = 64 * j + lane;
        const GAS v4u* kp = (const GAS v4u*)(F.K + (size_t)(rowb + s) * D + h * HD);
        float xs = 0.f;
#pragma unroll
        for (int i = 0; i < 8; ++i) { const v4u w = kp[i];
            xs += qd[8 * i + 0] * bf2f(w.x & 0xffffu); xs += qd[8 * i + 1] * bf2f(w.x >> 16); xs += qd[8 * i + 2] * bf2f(w.y & 0xffffu); xs += qd[8 * i + 3] * bf2f(w.y >> 16);
            xs += qd[8 * i + 4] * bf2f(w.z & 0xffffu); xs += qd[8 * i + 5] * bf2f(w.z >> 16); xs += qd[8 * i + 6] * bf2f(w.w & 0xffffu); xs += qd[8 * i + 7] * bf2f(w.w >> 16); }
        const bool valid = s < t;
        const float sp = valid ? (fmaxf(xs, 0.f) + __builtin_amdgcn_logf(1.0f + __builtin_amdgcn_exp2f(-fabsf(xs)))) : 0.f;
        float suf = sp;
#pragma unroll
        for (int off = 1; off < 64; off <<= 1) { const float v = __shfl_down(suf, off); if (lane + off < 64) suf += v; }
        const float w = valid ? __builtin_amdgcn_exp2f(xs - (suf + carry)) : 0.f;
        carry += __shfl(suf, 0);
        const GAS bf16* vp = (const GAS bf16*)(F.V + (size_t)(rowb + 64 * j) * D + h * HD + lane);
        for (int i = 0; i < 64; ++i) { const float wi = __shfl(w, i); o += wi * bf2f(vp[(size_t)i * D]); }
    }
    const size_t oo = (size_t)row * D + h * HD + lane;
    const float sz = bf2f(F.SZSB[oo]);
    F.ASB[oo] = (bf16)f2bf(o * sz);
}
__device__ __forceinline__ void attn_ref_phase(Frame& F) {
    const int gw = F.bid * NWAVES + F.wave, NGW = F.G * NWAVES;
    for (int it = gw; it < M * NH; it += NGW) attn_ref_task(F, it >> 4, it & 15);
}

namespace sba {
using f32x16 = __attribute__((ext_vector_type(16))) float;
using bf16x8 = __attribute__((ext_vector_type(8))) short;
using s16x4 = __attribute__((ext_vector_type(4))) short;
typedef short v4i16_t __attribute__((ext_vector_type(4)));
constexpr int VDH = 4160;
constexpr int WBYTES = 8448;
constexpr float ATT_EXIT = 1.0e-9f;

__device__ __forceinline__ unsigned cvtpk(float lo, float hi) { return pg8::cvt_pk_bf16(lo, hi); }
#if USE_F16
__device__ __forceinline__ f32x16 mfma32(bf16x8 a, bf16x8 b, f32x16 c) { return __builtin_amdgcn_mfma_f32_32x32x16_f16(__builtin_bit_cast(pg8::h16x8, a), __builtin_bit_cast(pg8::h16x8, b), c, 0, 0, 0); }
#else
__device__ __forceinline__ f32x16 mfma32(bf16x8 a, bf16x8 b, f32x16 c) { return __builtin_amdgcn_mfma_f32_32x32x16_bf16(a, b, c, 0, 0, 0); }
#endif
__device__ __forceinline__ s16x4 vtr(LAS unsigned char* p) { return __builtin_bit_cast(s16x4, __builtin_amdgcn_ds_read_tr16_b64_v4i16((LAS v4i16_t*)p)); }

template <bool MASK>
__device__ __forceinline__ void tile_weights(const f32x16& p0, const f32x16& p1, float (&w)[32], float& carry, int kv0, int start, int r32, int hi) {
    float e[32], c[32], G[8];
    const int hiLim = r32 - kv0 - 4 * hi, loLim = -start - 4 * hi;
#pragma unroll
    for (int idx = 0; idx < 32; ++idx) { const int kvc = (idx >= 16 ? 32 : 0) + (idx & 3) + 8 * ((idx & 15) >> 2);
        float xv = fminf(idx < 16 ? p0[idx] : p1[idx - 16], 64.f);
        if (MASK) xv = (kvc < hiLim && kvc >= loLim) ? xv : -1000.f;
        e[idx] = __builtin_amdgcn_exp2f(xv); }
#pragma unroll
    for (int g = 0; g < 8; ++g) {
        float s = 1.f;
#pragma unroll
        for (int k = 3; k >= 0; --k) { const int idx = 4 * g + k; const float r = __builtin_amdgcn_rcpf(1.0f + e[idx]); s = (k == 3) ? r : s * r; c[idx] = s; }
        G[g] = s;
    }
    float run = carry;
#pragma unroll
    for (int g = 7; g >= 0; --g) {
        const auto rr = __builtin_amdgcn_permlane32_swap(__float_as_uint(G[g]), __float_as_uint(G[g]), false, false);
        const float ev = __uint_as_float(rr[0]), od = __uint_as_float(rr[1]);
        const float tmp = run * od; const float off = hi ? run : tmp; run = tmp * ev;
#pragma unroll
        for (int k = 0; k < 4; ++k) { const int idx = 4 * g + k; w[idx] = e[idx] * (off * c[idx]); }
    }
    carry = run;
}

__device__ __forceinline__ void attn_task(Frame& F, int b, int h, int qblk, LAS unsigned char* vl) {
    const int lane = F.lane, r32 = lane & 31, hi = lane >> 5;
    const int tw = 32 * qblk; const size_t rowb = (size_t)b * SEQ;
    const bf16* Qw = F.Q + (rowb + tw) * D + h * HD;
    const bf16* Kh = F.K + rowb * D + h * HD + hi * 8; const bf16* Vh = F.V + rowb * D + h * HD + (lane & 7) * 8;
    bf16x8 qr[4];
#pragma unroll
    for (int d0 = 0; d0 < 4; ++d0) qr[d0] = *(const GAS bf16x8*)(Qw + (size_t)r32 * D + d0 * 16 + hi * 8);
    f32x16 o[2]; o[0] = f32x16{}; o[1] = f32x16{};
    float carry = 1.f;
    LAS unsigned char* vwr = vl + ((lane & 7) >> 2) * VDH + (lane >> 3) * 64 + (lane & 3) * 16;
    LAS unsigned char* vrd = vl + ((lane >> 4) & 1) * 32 + (lane & 3) * 8 + (4 * hi + ((lane & 15) >> 2)) * 64;
    bf16x8 kf[2][4]; v4u vr[8];
#define SBA_LOAD(st) do { \
        _Pragma("unroll") for (int hh = 0; hh < 2; ++hh) { int kr = (st) + 32 * hh + r32; kr = kr < 0 ? 0 : kr; \
            _Pragma("unroll") for (int d0 = 0; d0 < 4; ++d0) kf[hh][d0] = *(const GAS bf16x8*)(Kh + (size_t)kr * D + d0 * 16); } \
        _Pragma("unroll") for (int it = 0; it < 8; ++it) { int vrw = (st) + 8 * it + (lane >> 3); vrw = vrw < 0 ? 0 : vrw; vr[it] = *(const GAS v4u*)(Vh + (size_t)vrw * D); } } while (0)
    SBA_LOAD(tw - 32);
    for (int i = 0;; ++i) {
        const int start = tw - 32 - 64 * i;
        f32x16 p0 = f32x16{}, p1 = f32x16{};
#pragma unroll
        for (int d0 = 0; d0 < 4; ++d0) { p0 = mfma32(kf[0][d0], qr[d0], p0); p1 = mfma32(kf[1][d0], qr[d0], p1); }
#pragma unroll
        for (int it = 0; it < 8; ++it) *(LAS v4u*)(vwr + it * 512) = vr[it];
        SBA_LOAD(start - 64);
        float w[32];
        if (i == 0 || start < 0) tile_weights<true>(p0, p1, w, carry, start - tw, start, r32, hi);
        else tile_weights<false>(p0, p1, w, carry, start - tw, start, r32, hi);
        bf16x8 pa[4];
#pragma unroll
        for (int ks = 0; ks < 4; ++ks) { v4u t; t.x = cvtpk(w[8 * ks + 0], w[8 * ks + 1]); t.y = cvtpk(w[8 * ks + 2], w[8 * ks + 3]); t.z = cvtpk(w[8 * ks + 4], w[8 * ks + 5]); t.w = cvtpk(w[8 * ks + 6], w[8 * ks + 7]); pa[ks] = __builtin_bit_cast(bf16x8, t); }
#pragma unroll
        for (int d0 = 0; d0 < 2; ++d0)
#pragma unroll
            for (int ks = 0; ks < 4; ++ks) { const s16x4 lo = vtr(vrd + d0 * VDH + ks * 1024), hi4 = vtr(vrd + d0 * VDH + ks * 1024 + 512);
                const bf16x8 vf = (bf16x8){lo[0], lo[1], lo[2], lo[3], hi4[0], hi4[1], hi4[2], hi4[3]};
                o[d0] = mfma32(pa[ks], vf, o[d0]); }
        if (start - 64 <= -64 || __all(carry < ATT_EXIT)) break;
    }
#undef SBA_LOAD
    LAS float* stg = (LAS float*)vl;
#pragma unroll
    for (int r = 0; r < 16; ++r) { const int q = (r & 3) + 8 * (r >> 2) + 4 * hi;
#pragma unroll
        for (int d0 = 0; d0 < 2; ++d0) stg[q * 64 + d0 * 32 + r32] = o[d0][r]; }
    const bf16* Zw = F.SZSB + (rowb + tw) * D + h * HD; bf16* Ow = F.ASB + (rowb + tw) * D + h * HD;
#pragma unroll
    for (int it = 0; it < 4; ++it) { const int row = it * 8 + (lane >> 3), ch = lane & 7;
        const f32x4 a0 = *(const LAS f32x4*)(stg + row * 64 + ch * 8), a1 = *(const LAS f32x4*)(stg + row * 64 + ch * 8 + 4);
        pg8::f32x4 z0, z1; pg8::unpack8(*(const GAS pg8::u32x4*)(Zw + (size_t)row * D + ch * 8), z0, z1);
        *(GAS pg8::u32x4*)(Ow + (size_t)row * D + ch * 8) = pg8::pack8(a0 * z0, a1 * z1); }
}
__device__ __forceinline__ void attn_phase(Frame& F) {
    LAS unsigned char* vl = F.lds + F.wave * WBYTES;
    for (int it = 0;; ++it) {
        const int tsk = (it * F.G + F.bid) * NWAVES + F.wave;
        if (tsk >= NB * NH * (SEQ / 32)) break;
        const int bh = tsk >> 6, qblk = tsk & 63;
        attn_task(F, bh >> 4, bh & 15, qblk, vl);
    }
}
}

typedef float f32x2 __attribute__((ext_vector_type(2)));
__device__ __forceinline__ float dppf(float v, const int ctrl_unused) { return v; }
#define DPP_ADD(v, ctrl) ((v) + __builtin_bit_cast(float, __builtin_amdgcn_update_dpp(0, __builtin_bit_cast(int, (v)), (ctrl), 0xF, 0xF, true)))
__device__ __forceinline__ float row_allsum(float v) {
    v = DPP_ADD(v, 0xB1); v = DPP_ADD(v, 0x4E); v = DPP_ADD(v, 0x124); v = DPP_ADD(v, 0x128); return v;
}
__device__ __forceinline__ void conv_phase(Frame& F, const int dry = 0) {
    const int tid = F.tid, c = 2 * tid, lane = F.lane;
    f32x2 wv[CVK];
#pragma unroll
    for (int k = 0; k < CVK; ++k) wv[k] = *(const GAS f32x2*)(F.conv_w + k * D + c);
    const f32x2 cb = *(const GAS f32x2*)(F.conv_b + c), lg = *(const GAS f32x2*)(F.cln_g + c), lb = *(const GAS f32x2*)(F.cln_b + c);
    LAS float* red = (LAS float*)(F.lds + 69632);
    const int li = lane & 15, R = lane >> 4;
    for (int tile = F.bid; tile < M / 128; tile += F.G) {
        const int t0 = tile * 128;
        const GAS unsigned* Up = (const GAS unsigned*)(F.U + (size_t)t0 * D + c);
        GAS unsigned* Zp = (GAS unsigned*)(F.SZCV + (size_t)t0 * D + c);
        f32x2 ring[32];
        const bool has_hist = (t0 & (SEQ - 1)) != 0;
#pragma unroll
        for (int r = 2; r < 32; ++r) { unsigned w = 0u; if (has_hist) w = Up[(r - 32) * (D / 2)]; ring[r] = (f32x2){bf2f(w & 0xffffu), bf2f(w >> 16)}; }
        ring[0] = (f32x2){0.f, 0.f}; ring[1] = (f32x2){0.f, 0.f};
        unsigned pre[8], zpre[8];
#pragma unroll
        for (int e = 0; e < 8; ++e) { pre[e] = Up[e * (D / 2)]; zpre[e] = Zp[e * (D / 2)]; }
        for (int blk = 0; blk < 4; ++blk) {
#pragma unroll
            for (int g = 0; g < 4; ++g) {
                const int rb = 32 * blk + 8 * g;
                unsigned cur[8], zc[8];
#pragma unroll
                for (int e = 0; e < 8; ++e) { cur[e] = pre[e]; zc[e] = zpre[e]; }
#pragma unroll
                for (int e = 0; e < 8; ++e) { pre[e] = Up[(rb + 8 + e) * (D / 2)]; zpre[e] = Zp[(rb + 8 + e) * (D / 2)]; }
                f32x2 y[8]; float st[16];
#pragma unroll
                for (int e = 0; e < 8; ++e) { const int j = 8 * g + e;
                    ring[j] = (f32x2){bf2f(cur[e] & 0xffffu), bf2f(cur[e] >> 16)};
                    f32x2 a = cb;
#pragma unroll
                    for (int k = 0; k < CVK; ++k) a += wv[k] * ring[(j + 2 + k) & 31];
                    y[e] = a; st[2 * e] = a.x + a.y; st[2 * e + 1] = a.x * a.x + a.y * a.y; }
                float a8[8], b4[4];
#pragma unroll
                for (int i = 0; i < 8; ++i) { const auto rr = __builtin_amdgcn_permlane32_swap(__float_as_uint(st[i]), __float_as_uint(st[i + 8]), false, false); a8[i] = __uint_as_float(rr[0]) + __uint_as_float(rr[1]); }
#pragma unroll
                for (int i = 0; i < 4; ++i) { const auto rr = __builtin_amdgcn_permlane16_swap(__float_as_uint(a8[i]), __float_as_uint(a8[i + 4]), false, false); b4[i] = row_allsum(__uint_as_float(rr[0]) + __uint_as_float(rr[1])); }
                LAS float* rp = red + (g & 1) * 128;
                { const float val = li == 0 ? b4[0] : li == 1 ? b4[1] : li == 2 ? b4[2] : b4[3]; if (li < 4) rp[(4 * R + li) * 8 + F.wave] = val; }
                __syncthreads();
                float tot = 0.f;
                if (lane < 16) { const f32x4 p = *(const LAS f32x4*)(rp + lane * 8), q = *(const LAS f32x4*)(rp + lane * 8 + 4); tot = ((p.x + p.y) + (p.z + p.w)) + ((q.x + q.y) + (q.z + q.w)); }
#pragma unroll
                for (int e = 0; e < 8; ++e) {
                    const float s1 = __builtin_amdgcn_readlane(tot, 2 * e), s2 = __builtin_amdgcn_readlane(tot, 2 * e + 1);
                    const float mean = s1 * (1.f / D), var = fmaxf(s2 * (1.f / D) - mean * mean, 0.f);
                    const float rstd = 1.f / sqrtf(var + LN_EPS);
                    const f32x2 yn = ((y[e] - mean) * rstd) * lg + lb;
                    const unsigned res = pk2(yn.x * pg8::sigmoidf_(yn.x) * bf2f(zc[e] & 0xffffu), yn.y * pg8::sigmoidf_(yn.y) * bf2f(zc[e] >> 16));
                    if (!dry) Zp[(rb + e) * (D / 2)] = res; }
            }
        }
    }
}

__device__ __forceinline__ void lnpost_phase(Frame& F, const int dry = 0) {
    const int gw = F.bid * NWAVES + F.wave, NGW = F.G * NWAVES;
    for (int m = gw; m < M; m += NGW) {
        GAS f32x4* xr = (GAS f32x4*)(F.out + (size_t)m * D) + F.lane;
        f32x4 v[4]; float s = 0.f;
#pragma unroll
        for (int j = 0; j < 4; ++j) { v[j] = xr[64 * j]; s += (v[j].x + v[j].y) + (v[j].z + v[j].w); }
        const float mean = wave_sum(s) * (1.f / D); float s2 = 0.f;
#pragma unroll
        for (int j = 0; j < 4; ++j) { v[j] = v[j] - mean; s2 += (v[j].x * v[j].x + v[j].y * v[j].y) + (v[j].z * v[j].z + v[j].w * v[j].w); }
        const float rstd = 1.f / sqrtf(wave_sum(s2) * (1.f / D) + LN_EPS);
#pragma unroll
        for (int j = 0; j < 4; ++j) { const f32x4 g = *((const GAS f32x4*)F.lnp_g + F.lane + 64 * j), b = *((const GAS f32x4*)F.lnp_b + F.lane + 64 * j); const f32x4 res = (v[j] * rstd) * g + b; if (!dry) xr[64 * j] = res; }
    }
}

#ifndef PROBE_DRY_ALL
#define PROBE_DRY_ALL 1
#endif
struct Args { const float* in[13]; float* out; unsigned char* ws; int ph_lo, ph_hi, fused, dry, li, pad; };
constexpr int NPHASE = 8;
__global__ void __launch_bounds__(NWAVES * 64, 2) fwd_kernel(Args args) {
    extern __shared__ __attribute__((aligned(16))) unsigned char lds[];
    Frame F;
    F.lds = (LAS unsigned char*)lds;
    F.tid = threadIdx.x; F.lane = F.tid & 63; F.wave = __builtin_amdgcn_readfirstlane(F.tid >> 6); F.G = gridDim.x; F.bid = blockIdx.x;
    unsigned char* ws = args.ws;
    F.x = args.in[0]; F.ln_in_g = args.in[1]; F.ln_in_b = args.in[2]; F.w_in = args.in[3]; F.w_sb = args.in[4]; F.conv_w = args.in[5]; F.conv_b = args.in[6];
    F.cln_g = args.in[7]; F.cln_b = args.in[8]; F.w_cv = args.in[9]; F.w_out = args.in[10]; F.lnp_g = args.in[11]; F.lnp_b = args.in[12];
    F.out = args.out; F.stats = (float*)(ws + WS_STATS);
    F.WIN = (bf16*)(ws + WS_WIN); F.WSB = (bf16*)(ws + WS_WSB); F.WCV = (bf16*)(ws + WS_WCV); F.WOUT = (bf16*)(ws + WS_WOUT);
    F.XN = (bf16*)args.out; F.ASB = (bf16*)args.out; F.Q = (bf16*)args.out + (size_t)M * D;
    F.K = (bf16*)(ws + WS_K); F.V = (bf16*)(ws + WS_V); F.SZSB = (bf16*)(ws + WS_SZSB); F.U = (bf16*)(ws + WS_U); F.SZCV = (bf16*)(ws + WS_SZCV);
    F.SGSB = (bf16*)(ws + WS_SGSB); F.SGCV = (bf16*)(ws + WS_SGCV); F.MERGED = (bf16*)(ws + WS_MERGED); F.P = (bf16*)(ws + WS_P);
    const int lo = args.ph_lo, hi = args.ph_hi; const bool fused = args.fused != 0;
    volatile LAS unsigned* bst = (volatile LAS unsigned*)(F.lds + BAR_LDS_OFF);
    if (F.tid < 2) bst[F.tid] = 0u;
    __syncthreads();
    XcdBarrier bar; bar.bar = (unsigned*)(ws + WS_CTL) + CW_BAR + args.li * XCD_BAR_WORDS; bar.x = 0; bar.st = nullptr;
    if (fused) bar = xcd_barrier_post((unsigned*)(ws + WS_CTL) + CW_BAR + args.li * XCD_BAR_WORDS, bst);
#define IN(k) (lo <= (k) && (k) < hi)
#if defined(USE_CG_SYNC)
#define SEAM(k) do { if (fused && IN(k) && IN((k) + 1)) { cg::this_grid().sync(); } } while (0)
#else
#define SEAM(k) do { if (fused && IN(k) && IN((k) + 1)) { xcd_barrier(bar); } } while (0)
#endif

    if (IN(0)) { p0_prologue(F); } SEAM(0);
    if (IN(1)) {
        pg8::Gemm g{F.XN, F.WIN, M, NIN, D}; pg8::StaggerOrder S; S.init2(M, NIN, F.G, F.bid, (F.G == 256) ? (F.bid & 1) : 0);
        pg8::f32x4* part = (pg8::f32x4*)(ws + WS_PART) + (size_t)(F.bid >> 1) * (65536 / 4);
        pg8::EpiIn E{F.Q, F.K, F.V, F.SZSB, F.U, F.SZCV, F.SGSB, F.SGCV, (args.dry & 2) && (PROBE_DRY_ALL || ((F.bid >> 3) & 1))};
        pg8::gemm_phase<pg8::EpiIn, pg8::StaggerOrder, true, true>(F.lds, g, S, E, part);
    } SEAM(1);
    #if defined(ATTN_REF)
    if (IN(2)) { attn_ref_phase(F); }
    if (IN(3)) { conv_phase(F, args.dry & 8); } SEAM(3);
#else
    if (IN(2)) { sba::attn_phase(F); }
    if (IN(3)) { conv_phase(F, args.dry & 8); } SEAM(3);
#endif
    if (IN(4)) {
        pg8::Gemm g{F.ASB, F.WSB, M, D, D}; pg8::StaticOrder S; S.init(M, D, F.G, F.bid);
        pg8::EpiGate E{F.SGSB, F.P};
        pg8::gemm_phase<pg8::EpiGate, pg8::StaticOrder, true, true>(F.lds, g, S, E);
    } SEAM(4);
    if (IN(5)) {
        pg8::Gemm g{F.SZCV, F.WCV, M, D, D}; pg8::StaticOrder S; S.init(M, D, F.G, F.bid);
        pg8::EpiGateAdd E{F.SGCV, F.P, F.MERGED};
        pg8::gemm_phase<pg8::EpiGateAdd, pg8::StaticOrder, true, true>(F.lds, g, S, E);
    } SEAM(5);
    if (IN(6)) {
        pg8::Gemm g{F.MERGED, F.WOUT, M, D, D}; pg8::StaticOrder S; S.init(M, D, F.G, F.bid);
        pg8::EpiOut E{F.x, F.stats, F.ln_in_g, F.ln_in_b, F.out, DN_ALPHA};
        pg8::gemm_phase<pg8::EpiOut, pg8::StaticOrder, true, true>(F.lds, g, S, E);
    } SEAM(6);
    if (IN(7)) { lnpost_phase(F, args.dry & 128); }
#undef IN
#undef SEAM
}

#ifndef MK_N_LAUNCHES
#define MK_N_LAUNCHES 1
#endif
extern "C" void kernel_launch(void* const* d_in, const int* in_sizes, int n_in, void* d_out, int out_size, void* d_ws, size_t ws_size, hipStream_t stream) {
    static int grid = 0;
    if (grid == 0) {
        if (n_in != 13 || in_sizes[0] != M * D || out_size != M * D || ws_size < WS_END) { fprintf(stderr, "kernel_launch: unexpected shapes (n_in %d, in0 %d, out %d, ws %zu); nothing launched\n", n_in, n_in > 0 ? in_sizes[0] : -1, out_size, ws_size); grid = -1; return; }
        int dev = 0, cus = 0, per_cu = 0;
        if (hipGetDevice(&dev) != hipSuccess || hipDeviceGetAttribute(&cus, hipDeviceAttributeMultiprocessorCount, dev) != hipSuccess) { grid = -1; return; }
        if (hipFuncSetAttribute((const void*)fwd_kernel, hipFuncAttributeMaxDynamicSharedMemorySize, LDS_BYTES) != hipSuccess) { fprintf(stderr, "kernel_launch: hipFuncSetAttribute failed\n"); grid = -1; return; }
        if (hipOccupancyMaxActiveBlocksPerMultiprocessor(&per_cu, (const void*)fwd_kernel, NWAVES * 64, LDS_BYTES) != hipSuccess || per_cu < 1) { fprintf(stderr, "kernel_launch: occupancy query says %d blocks per CU\n", per_cu); (void)hipGetLastError(); grid = -1; return; }
        grid = cus * (per_cu < 1 ? 1 : 1);
    }
    if (grid < 0) return;
    if (hipMemsetAsync((char*)d_ws + WS_CTL, 0, CTL_ZERO_BYTES, stream) != hipSuccess) { fprintf(stderr, "kernel_launch: hipMemsetAsync failed\n"); return; }
    Args a{};
    for (int i = 0; i < 13; ++i) a.in[i] = (const float*)d_in[i];
    a.out = (float*)d_out; a.ws = (unsigned char*)d_ws;
#if defined(PROBE_SPLIT)
    for (int li = 0; li < 2; ++li) {
        a.ph_lo = li == 0 ? 0 : PROBE_SPLIT; a.ph_hi = li == 0 ? PROBE_SPLIT + 1 : NPHASE; a.fused = 1; a.li = li;
#if defined(PROBE_DRY)
        a.dry = li == 0 ? (1 << PROBE_SPLIT) : 0;
#endif
        void* kargs[] = {&a};
        hipError_t e = hipLaunchCooperativeKernel((const void*)fwd_kernel, dim3(grid), dim3(NWAVES * 64), kargs, LDS_BYTES, stream);
        if (e != hipSuccess) fprintf(stderr, "kernel_launch: cooperative launch failed: %s (grid %d)\n", hipGetErrorString(e), grid);
    }
#else
    if (MK_N_LAUNCHES == 1) {
        a.ph_lo = 0; a.ph_hi = NPHASE; a.fused = 1;
        void* kargs[] = {&a};
        hipError_t e = hipLaunchCooperativeKernel((const void*)fwd_kernel, dim3(grid), dim3(NWAVES * 64), kargs, LDS_BYTES, stream);
        if (e != hipSuccess) fprintf(stderr, "kernel_launch: cooperative launch failed: %s (grid %d)\n", hipGetErrorString(e), grid);
    } else {
        for (int ph = 0; ph < NPHASE; ++ph) {
            a.ph_lo = ph; a.ph_hi = ph + 1; a.fused = 0;
            hipLaunchKernelGGL(fwd_kernel, dim3(grid), dim3(NWAVES * 64), LDS_BYTES, stream, a);
        }
    }
#endif
}
```

```cpp
#include <hip/hip_runtime.h>
#include <hip/hip_cooperative_groups.h>
#include <cstdio>
#include <cstdint>
namespace cg = cooperative_groups;

namespace pg8 {
#define PG8_LAS __attribute__((address_space(3)))
typedef unsigned short bf16_t;
typedef short bf16x8 __attribute__((ext_vector_type(8)));
typedef float f32x4 __attribute__((ext_vector_type(4)));
typedef unsigned u32x4 __attribute__((ext_vector_type(4)));
constexpr int BM = 256, BK = 64, HALF = 128, HTB = HALF * BK * 2  , STAGE_BYTES = 8 * HTB, NXCD = 8, WGM = 8;

__host__ __device__ __forceinline__ int lds_byte(int r, int c) { const int st = (r >> 4) * 2 + (c >> 5), rr = r & 15, cc = c & 31, ob = rr * 64 + cc * 2; return st * 1024 + (ob ^ (((ob >> 9) & 1) << 5)); }
__host__ __device__ __forceinline__ void stage_rc(int b, int& R, int& C) { const int st = b / 1024, sb = b % 1024, swz = sb ^ (((sb >> 9) & 1) << 5); R = (st >> 1) * 16 + swz / 64; C = (st & 1) * 32 + (swz % 64) / 2; }
__host__ __device__ __forceinline__ int perm32(int rho) { const int n = rho >> 4, i = rho & 15; return 8 * (i >> 2) + 4 * n + (i & 3); }

struct Unit { int pm, pn, kt0, nkt, mode; };
struct Gemm { const bf16_t* A; const bf16_t* Bt; int M, N, K; };

struct StaticOrder {
    int nM, nN, nwg, G, c, nkt;
    __host__ __device__ void init(int M, int N, int G_, int c_, int K = 1024) { nM = M / BM; nN = N / BM; nwg = nM * nN; G = G_; c = c_; nkt = K / BK; }
    __host__ __device__ bool next(int i, Unit& u) const {
        const long L = (long)i * G + c; if (L >= nwg) return false;
        int wgid = (int)L; { const int q = nwg / NXCD, r = nwg % NXCD, xcd = wgid % NXCD, off = wgid / NXCD; wgid = (xcd < r ? xcd * (q + 1) : r * (q + 1) + (xcd - r) * q) + off; }
        const int nig = WGM * nN, gid = wgid / nig, fm = gid * WGM, gsz = (nM - fm) < WGM ? (nM - fm) : WGM;
        u.pm = fm + ((wgid % nig) % gsz); u.pn = (wgid % nig) / gsz; u.kt0 = 0; u.nkt = nkt; u.mode = 0; return true;
    }
    __device__ __forceinline__ void a_ready(const Unit&) const {}
    __device__ __forceinline__ void done(const Unit&) const {}
};

struct StaggerOrder : StaticOrder {
    int stag, n;
    __host__ __device__ void init2(int M, int N, int G_, int c_, int stag_, int K = 1024) { init(M, N, G_, c_, K); stag = stag_; n = (nwg - c + G - 1) / G; if (n < 2 || (nkt & 3)) stag = 0; }
    __host__ __device__ bool next(int i, Unit& u) const {
        if (!stag) return StaticOrder::next(i, u);
        if (i > n) return false;
        if (i == 0) { StaticOrder::next(0, u); u.nkt = nkt / 2; u.mode = 1; return true; }
        if (i == n) { StaticOrder::next(0, u); u.kt0 = nkt / 2; u.nkt = nkt / 2; u.mode = 2; return true; }
        return StaticOrder::next(i, u);
    }
};

#ifndef USE_F16
#define USE_F16 0
#endif
typedef _Float16 h16x2 __attribute__((ext_vector_type(2)));
typedef _Float16 h16x8 __attribute__((ext_vector_type(8)));
typedef float f32x2p __attribute__((ext_vector_type(2)));
#if USE_F16
__device__ __forceinline__ unsigned cvt_pk_bf16(float lo, float hi) { const f32x2p v = {lo, hi}; return __builtin_bit_cast(unsigned, __builtin_convertvector(v, h16x2)); }
__device__ __forceinline__ float bflo(unsigned w) { return (float)__builtin_bit_cast(h16x2, w)[0]; }
__device__ __forceinline__ float bfhi(unsigned w) { return (float)__builtin_bit_cast(h16x2, w)[1]; }
__device__ __forceinline__ f32x4 mfma16(bf16x8 a, bf16x8 b, f32x4 c) { return __builtin_amdgcn_mfma_f32_16x16x32_f16(__builtin_bit_cast(h16x8, a), __builtin_bit_cast(h16x8, b), c, 0, 0, 0); }
#else
__device__ __forceinline__ unsigned cvt_pk_bf16(float lo, float hi) { unsigned r; asm volatile("v_cvt_pk_bf16_f32 %0, %1, %2" : "=v"(r) : "v"(lo), "v"(hi)); return r; }
__device__ __forceinline__ float bflo(unsigned w) { return __uint_as_float(w << 16); }
__device__ __forceinline__ float bfhi(unsigned w) { return __uint_as_float(w & 0xffff0000u); }
__device__ __forceinline__ f32x4 mfma16(bf16x8 a, bf16x8 b, f32x4 c) { return __builtin_amdgcn_mfma_f32_16x16x32_bf16(a, b, c, 0, 0, 0); }
#endif
__device__ __forceinline__ float sigmoidf_(float x) { return __builtin_amdgcn_rcpf(1.0f + __builtin_amdgcn_exp2f(-1.4426950408889634f * x)); }
__device__ __forceinline__ f32x4 sig4(f32x4 v) { return (f32x4){sigmoidf_(v[0]), sigmoidf_(v[1]), sigmoidf_(v[2]), sigmoidf_(v[3])}; }
__device__ __forceinline__ u32x4 pack8(f32x4 v0, f32x4 v1) { u32x4 w; w.x = cvt_pk_bf16(v0[0], v0[1]); w.y = cvt_pk_bf16(v0[2], v0[3]); w.z = cvt_pk_bf16(v1[0], v1[1]); w.w = cvt_pk_bf16(v1[2], v1[3]); return w; }
__device__ __forceinline__ void unpack8(u32x4 w, f32x4& v0, f32x4& v1) { v0 = (f32x4){bflo(w.x), bfhi(w.x), bflo(w.y), bfhi(w.y)}; v1 = (f32x4){bflo(w.z), bfhi(w.z), bflo(w.w), bfhi(w.w)}; }

#ifndef EPI_STORE_AUX
#define EPI_STORE_AUX 16
#endif
__device__ __forceinline__ void store16(bf16_t* base, unsigned byte_off, u32x4 v) {
#if EPI_STORE_AUX == 0
    *(u32x4*)((char*)base + byte_off) = v;
#else
    __builtin_amdgcn_raw_buffer_store_b128(v, __builtin_amdgcn_make_buffer_rsrc(base, 0, 0x4000000, 0x00020000), byte_off, 0, EPI_STORE_AUX);
#endif
}
constexpr float QSCALE = 0.125f * 1.4426950408889634f;

struct EpiIn {
    static constexpr bool PERM = true, AFTER_DRAIN = false;
    bf16_t *Q, *Kb, *Vb, *SZSB, *U, *SZCV, *SGSB, *SGCV; int dry;
    __device__ __forceinline__ void operator()(const f32x4 (&acc)[2][2][4][2], const Unit& u, int wr, int wc, int fr, int fq) const {
        const int row0 = u.pm * BM + wr * 64 + fr; const int pn = u.pn;
        if (pn >= 16 && pn < 24) {
            const unsigned col = (pn - 16) * 128 + wc * 32 + 8 * fq;
#pragma unroll
            for (int ai = 0; ai < 2; ++ai)
#pragma unroll
                for (int m = 0; m < 4; ++m) { const unsigned off = ((unsigned)(row0 + ai * HALF + m * 16) * 1024u + col) * 2u;
                    const f32x4 v0 = acc[ai][0][m][0] * sig4(acc[ai][1][m][0]), v1 = acc[ai][0][m][1] * sig4(acc[ai][1][m][1]);
                    const u32x4 pk = pack8(v0, v1); if (!dry) store16(U, off, pk); }
            return;
        }
        const int grp = pn >> 2; int mode; bf16_t* base;
        float sc = 1.f;
        if (grp == 0) { base = Q; mode = 0; sc = QSCALE; } else if (grp == 1) { base = Kb; mode = 0; } else if (grp == 2) { base = Vb; mode = 0; }
        else if (grp == 3) { base = SZSB; mode = 1; } else if (grp == 6) { base = SZCV; mode = 1; } else if (grp == 7) { base = SGSB; mode = 2; } else { base = SGCV; mode = 2; }
        const unsigned col = (pn & 3) * BM + wc * 32 + 8 * fq;
#pragma unroll
        for (int ai = 0; ai < 2; ++ai)
#pragma unroll
            for (int m = 0; m < 4; ++m) { const unsigned off = ((unsigned)(row0 + ai * HALF + m * 16) * 1024u + col) * 2u;
#pragma unroll
                for (int bj = 0; bj < 2; ++bj) { f32x4 v0 = acc[ai][bj][m][0], v1 = acc[ai][bj][m][1];
                    if (mode == 0) { v0 = v0 * sc; v1 = v1 * sc; }
                    else if (mode == 1) { v0 = v0 * sig4(v0); v1 = v1 * sig4(v1); }
                    else { v0 = sig4(v0); v1 = sig4(v1); }
                    const u32x4 pk = pack8(v0, v1); if (!dry) store16(base, off + bj * HALF * 2, pk); } }
    }
};
struct EpiGate {
    static constexpr bool PERM = true, AFTER_DRAIN = false;
    const bf16_t* G; bf16_t* P;
    __device__ __forceinline__ void operator()(const f32x4 (&acc)[2][2][4][2], const Unit& u, int wr, int wc, int fr, int fq) const {
        const int row0 = u.pm * BM + wr * 64 + fr, col0 = u.pn * BM + wc * 32 + 8 * fq;
#pragma unroll
        for (int ai = 0; ai < 2; ++ai)
#pragma unroll
            for (int m = 0; m < 4; ++m) { const size_t off = (size_t)(row0 + ai * HALF + m * 16) * 1024 + col0;
#pragma unroll
                for (int bj = 0; bj < 2; ++bj) { f32x4 g0, g1; unpack8(*(const u32x4*)(G + off + bj * HALF), g0, g1);
                    *(u32x4*)(P + off + bj * HALF) = pack8(acc[ai][bj][m][0] * g0, acc[ai][bj][m][1] * g1); } }
    }
};
struct EpiGateAdd {
    static constexpr bool PERM = true, AFTER_DRAIN = false;
    const bf16_t* G; const bf16_t* P; bf16_t* O;
    __device__ __forceinline__ void operator()(const f32x4 (&acc)[2][2][4][2], const Unit& u, int wr, int wc, int fr, int fq) const {
        const int row0 = u.pm * BM + wr * 64 + fr, col0 = u.pn * BM + wc * 32 + 8 * fq;
#pragma unroll
        for (int ai = 0; ai < 2; ++ai)
#pragma unroll
            for (int m = 0; m < 4; ++m) { const size_t off = (size_t)(row0 + ai * HALF + m * 16) * 1024 + col0;
#pragma unroll
                for (int bj = 0; bj < 2; ++bj) { f32x4 g0, g1, p0, p1; unpack8(*(const u32x4*)(G + off + bj * HALF), g0, g1); unpack8(*(const u32x4*)(P + off + bj * HALF), p0, p1);
                    *(u32x4*)(O + off + bj * HALF) = pack8(p0 + acc[ai][bj][m][0] * g0, p1 + acc[ai][bj][m][1] * g1); } }
    }
};
struct EpiOut {
    static constexpr bool PERM = false, AFTER_DRAIN = false;
    const float* x; const float* stats; const float* g; const float* b; float* C; float alpha;
    __device__ __forceinline__ void operator()(const f32x4 (&acc)[2][2][4][2], const Unit& u, int wr, int wc, int fr, int fq) const {
        const int row0 = u.pm * BM + wr * 64 + fr, col0 = u.pn * BM + wc * 32 + 4 * fq;
        f32x4 gv[2][2], bv[2][2];
#pragma unroll
        for (int bj = 0; bj < 2; ++bj)
#pragma unroll
            for (int n = 0; n < 2; ++n) { gv[bj][n] = *(const f32x4*)(g + col0 + bj * HALF + n * 16) * alpha; bv[bj][n] = *(const f32x4*)(b + col0 + bj * HALF + n * 16) * alpha; }
#pragma unroll
        for (int ai = 0; ai < 2; ++ai)
#pragma unroll
            for (int m = 0; m < 4; ++m) { const int row = row0 + ai * HALF + m * 16; const size_t off = (size_t)row * 1024 + col0;
                const float mu = stats[2 * row], rs = stats[2 * row + 1];
#pragma unroll
                for (int bj = 0; bj < 2; ++bj)
#pragma unroll
                    for (int n = 0; n < 2; ++n) { const f32x4 xv = *(const f32x4*)(x + off + bj * HALF + n * 16);
                        *(f32x4*)(C + off + bj * HALF + n * 16) = ((xv - mu) * rs) * gv[bj][n] + bv[bj][n] + acc[ai][bj][m][n]; } }
    }
};

template <class Epi, class Sched, bool ALIGN_EPI = false, bool SP2 = false>
__device__ __forceinline__ void gemm_phase(PG8_LAS unsigned char* lds, const Gemm g, const Sched& S, const Epi& E, f32x4* part = nullptr) {
    const int tid = threadIdx.x, wid = __builtin_amdgcn_readfirstlane(tid >> 6), lane = tid & 63, wr = wid >> 2, wc = wid & 3, fr = lane & 15, fq = lane >> 4;
    const int K = g.K;
    unsigned voffA[2], voffB[2];
#pragma unroll
    for (int i = 0; i < 2; ++i) { int R, C; stage_rc(tid * 16 + i * 8192, R, C); const int Rb = Epi::PERM ? ((R & ~31) + perm32(R & 31)) : R;
        voffA[i] = (unsigned)(R * K + C) * 2u; voffB[i] = (unsigned)(Rb * K + C) * 2u; }
    const size_t kstep = (size_t)(BK * 2);
    const size_t hstep = (size_t)HALF * K * 2;
    const size_t tstep = 2 * hstep;
    const unsigned ldsw = (unsigned)wid * 1024u;
    const int aoff = lds_byte(wr * 64 + fr, fq * 8), boff = lds_byte(wc * 32 + fr, fq * 8);
#define PG8_SA(b, h) (((b) * 2 + (h)) * HTB)
#define PG8_SB(b, h) ((4 + (b) * 2 + (h)) * HTB)
#define PG8_STAGE(bufoff, gbase, voff) do { _Pragma("unroll") for (int _i = 0; _i < 2; ++_i) \
        __builtin_amdgcn_global_load_lds((const unsigned*)((const char*)(gbase) + (voff)[_i]), (PG8_LAS unsigned*)(lds + (bufoff) + ldsw + _i * 8192), 16, 0, 0); } while (0)
#define PG8_LDA(dst, b, h) do { _Pragma("unroll") for (int m = 0; m < 4; ++m) _Pragma("unroll") for (int k = 0; k < 2; ++k) dst[m][k] = *(const PG8_LAS bf16x8*)(lds + PG8_SA(b, h) + aoff + m * 2048 + k * 1024); } while (0)
#define PG8_LDB(dst, b, h) do { _Pragma("unroll") for (int n = 0; n < 2; ++n) _Pragma("unroll") for (int k = 0; k < 2; ++k) dst[n][k] = *(const PG8_LAS bf16x8*)(lds + PG8_SB(b, h) + boff + n * 2048 + k * 1024); } while (0)
#define PG8_MMA(ai, bj, At, Bt) do { __builtin_amdgcn_s_setprio(1); _Pragma("unroll") for (int m = 0; m < 4; ++m) _Pragma("unroll") for (int n = 0; n < 2; ++n) _Pragma("unroll") for (int k = 0; k < 2; ++k) \
        acc[ai][bj][m][n] = mfma16(Bt[n][k], At[m][k], acc[ai][bj][m][n]); __builtin_amdgcn_s_setprio(0); } while (0)
#define PG8_WAIT_V(n) asm volatile("s_waitcnt vmcnt(" #n ")" ::: "memory")
#define PG8_WAIT_L(n) asm volatile("s_waitcnt lgkmcnt(" #n ")" ::: "memory")
#define PG8_BAR __builtin_amdgcn_s_barrier()
#define PG8_SCHED __builtin_amdgcn_sched_barrier(0)
    Unit cur, nxt; int ui = 0;
    if (!S.next(0, cur)) return;
    f32x4 acc[2][2][4][2];
#pragma unroll
    for (int a = 0; a < 2; ++a)
#pragma unroll
        for (int b = 0; b < 2; ++b)
#pragma unroll
            for (int m = 0; m < 4; ++m)
#pragma unroll
                for (int n = 0; n < 2; ++n) acc[a][b][m][n] = (f32x4){0.f, 0.f, 0.f, 0.f};
    bf16x8 At[4][2], B0[2][2], B1[2][2];
    const char* cA = (const char*)g.A + (size_t)cur.pm * tstep + (size_t)cur.kt0 * (BK * 2); const char* cB = (const char*)g.Bt + (size_t)cur.pn * tstep + (size_t)cur.kt0 * (BK * 2);
    S.a_ready(cur);
    if constexpr (SP2) {
        PG8_STAGE(PG8_SB(0, 0), cB, voffB); PG8_STAGE(PG8_SB(0, 1), cB + hstep, voffB); PG8_STAGE(PG8_SA(0, 0), cA, voffA); PG8_STAGE(PG8_SA(0, 1), cA + hstep, voffA);
        if (wr == 1) PG8_BAR;
        PG8_WAIT_V(2); PG8_BAR;
        PG8_STAGE(PG8_SB(1, 0), cB + kstep, voffB); PG8_STAGE(PG8_SA(1, 0), cA + kstep, voffA); PG8_STAGE(PG8_SB(1, 1), cB + hstep + kstep, voffB);
        PG8_WAIT_V(6); PG8_BAR;
    } else {
        PG8_STAGE(PG8_SB(0, 0), cB, voffB); PG8_STAGE(PG8_SA(0, 0), cA, voffA); PG8_STAGE(PG8_SB(0, 1), cB + hstep, voffB); PG8_STAGE(PG8_SA(0, 1), cA + hstep, voffA);
        if (wr == 1) PG8_BAR;
        PG8_WAIT_V(4); PG8_BAR;
        PG8_STAGE(PG8_SB(1, 0), cB + kstep, voffB); PG8_STAGE(PG8_SA(1, 0), cA + kstep, voffA); PG8_STAGE(PG8_SB(1, 1), cB + hstep + kstep, voffB);
        PG8_WAIT_V(6); PG8_BAR;
    }
    for (;;) {
        const bool has_next = S.next(ui + 1, nxt);
        const char* nA = has_next ? (const char*)g.A + (size_t)nxt.pm * tstep + (size_t)nxt.kt0 * (BK * 2) : cA; const char* nB = has_next ? (const char*)g.Bt + (size_t)nxt.pn * tstep + (size_t)nxt.kt0 * (BK * 2) : cB;
        const int nt = cur.nkt;
        for (int t = 0; t < nt; t += 2) {
            const bool last = (t == nt - 2);
            const char* a1 = cA + (size_t)(t + 1) * kstep;
            const char* a2 = last ? nA : cA + (size_t)(t + 2) * kstep; const char* b2 = last ? nB : cB + (size_t)(t + 2) * kstep;
            const char* a3 = a2 + kstep; const char* b3 = b2 + kstep;
            if (last && has_next) S.a_ready(nxt);
            if constexpr (SP2) {
            PG8_LDB(B0, 0, 0); PG8_LDB(B1, 0, 1); PG8_SCHED; PG8_LDA(At, 0, 0); PG8_STAGE(PG8_SA(1, 1), a1 + hstep, voffA);
            PG8_WAIT_V(8); PG8_WAIT_L(0); PG8_BAR; PG8_MMA(0, 0, At, B0); PG8_MMA(0, 1, At, B1); PG8_BAR; PG8_SCHED;
            PG8_LDA(At, 0, 1); PG8_STAGE(PG8_SB(0, 0), b2, voffB); PG8_STAGE(PG8_SB(0, 1), b2 + hstep, voffB); PG8_STAGE(PG8_SA(0, 0), a2, voffA);
            PG8_WAIT_V(8); PG8_WAIT_L(0); PG8_BAR; PG8_MMA(1, 0, At, B0); PG8_MMA(1, 1, At, B1); PG8_BAR; PG8_SCHED;
            PG8_LDB(B0, 1, 0); PG8_LDB(B1, 1, 1); PG8_SCHED; PG8_LDA(At, 1, 0); PG8_STAGE(PG8_SA(0, 1), a2 + hstep, voffA);
            PG8_WAIT_V(8); PG8_WAIT_L(0); PG8_BAR; PG8_MMA(0, 0, At, B0); PG8_MMA(0, 1, At, B1); PG8_BAR; PG8_SCHED;
            PG8_LDA(At, 1, 1); PG8_STAGE(PG8_SB(1, 0), b3, voffB); PG8_STAGE(PG8_SB(1, 1), b3 + hstep, voffB); PG8_STAGE(PG8_SA(1, 0), a3, voffA);
            PG8_WAIT_V(8); PG8_WAIT_L(0); PG8_BAR; PG8_MMA(1, 0, At, B0); PG8_MMA(1, 1, At, B1); PG8_BAR; PG8_SCHED;
            } else {
            PG8_LDB(B0, 0, 0); PG8_SCHED; PG8_LDA(At, 0, 0); PG8_STAGE(PG8_SA(1, 1), a1 + hstep, voffA);
            PG8_WAIT_L(8); PG8_BAR; PG8_WAIT_L(0); PG8_MMA(0, 0, At, B0); PG8_BAR; PG8_SCHED;
            PG8_LDB(B1, 0, 1); PG8_STAGE(PG8_SB(0, 0), b2, voffB);
            PG8_BAR; PG8_WAIT_L(0); PG8_MMA(0, 1, At, B1); PG8_BAR;
            PG8_LDA(At, 0, 1); PG8_STAGE(PG8_SA(0, 0), a2, voffA);
            PG8_BAR; PG8_WAIT_L(0); PG8_MMA(1, 0, At, B0); PG8_BAR; PG8_SCHED;
            PG8_STAGE(PG8_SB(0, 1), b2 + hstep, voffB);
            PG8_WAIT_V(6); PG8_BAR; PG8_MMA(1, 1, At, B1); PG8_BAR;
            PG8_LDB(B0, 1, 0); PG8_SCHED; PG8_LDA(At, 1, 0); PG8_STAGE(PG8_SA(0, 1), a2 + hstep, voffA);
            PG8_WAIT_L(8); PG8_BAR; PG8_WAIT_L(0); PG8_MMA(0, 0, At, B0); PG8_BAR; PG8_SCHED;
            PG8_LDB(B1, 1, 1); PG8_STAGE(PG8_SB(1, 0), b3, voffB);
            PG8_BAR; PG8_WAIT_L(0); PG8_MMA(0, 1, At, B1); PG8_BAR;
            PG8_LDA(At, 1, 1); PG8_STAGE(PG8_SA(1, 0), a3, voffA);
            PG8_BAR; PG8_WAIT_L(0); PG8_MMA(1, 0, At, B0); PG8_BAR; PG8_SCHED;
            PG8_STAGE(PG8_SB(1, 1), b3 + hstep, voffB);
            PG8_WAIT_V(6); PG8_BAR; PG8_MMA(1, 1, At, B1); PG8_BAR;
            }
        }
        if constexpr (ALIGN_EPI) { if (wr == 0) PG8_BAR; }
        if (cur.mode == 1) {
            __attribute__((address_space(1))) f32x4* pp = (__attribute__((address_space(1))) f32x4*)part + tid;
#pragma unroll
            for (int a = 0; a < 2; ++a)
#pragma unroll
                for (int b = 0; b < 2; ++b)
#pragma unroll
                    for (int m = 0; m < 4; ++m)
#pragma unroll
                        for (int n = 0; n < 2; ++n) { *pp = acc[a][b][m][n]; pp += 512; asm volatile("" : "+v"(pp)); }
        } else
        if constexpr (!Epi::AFTER_DRAIN) { E(acc, cur, wr, wc, fr, fq); S.done(cur); }
        if (!has_next) break;
        if (nxt.mode == 2) {
            const __attribute__((address_space(1))) f32x4* pp = (const __attribute__((address_space(1))) f32x4*)part + tid;
#pragma unroll
            for (int a = 0; a < 2; ++a)
#pragma unroll
                for (int b = 0; b < 2; ++b)
#pragma unroll
                    for (int m = 0; m < 4; ++m)
#pragma unroll
                        for (int n = 0; n < 2; ++n) { acc[a][b][m][n] = *pp; pp += 512; asm volatile("" : "+v"(pp)); }
        } else {
#pragma unroll
        for (int a = 0; a < 2; ++a)
#pragma unroll
            for (int b = 0; b < 2; ++b)
#pragma unroll
                for (int m = 0; m < 4; ++m)
#pragma unroll
                    for (int n = 0; n < 2; ++n) acc[a][b][m][n] = (f32x4){0.f, 0.f, 0.f, 0.f};
        }
        cur = nxt; cA = nA; cB = nB; ++ui;
        if constexpr (ALIGN_EPI) { if (wr == 1) PG8_BAR; }
    }
    PG8_WAIT_V(0);
    if constexpr (!ALIGN_EPI) { if (wr == 0) PG8_BAR; }
    PG8_BAR;
    if constexpr (Epi::AFTER_DRAIN) { E.fused(acc, cur, wr, wc, fr, fq, lds, wid, lane); S.done(cur); }
#undef PG8_SA
#undef PG8_SB
#undef PG8_STAGE
#undef PG8_LDA
#undef PG8_LDB
#undef PG8_MMA
#undef PG8_WAIT_V
#undef PG8_WAIT_L
#undef PG8_BAR
#undef PG8_SCHED
}
}

constexpr int NWAVES = 8;
constexpr int NB = 16, SEQ = 2048, D = 1024, NH = 16, HD = 64, NIN = 9216, CVK = 31;
constexpr int M = NB * SEQ;
constexpr float LN_EPS = 1e-5f;
constexpr float DN_ALPHA = 1.189207115002721f;

constexpr size_t MiB = 1u << 20;
constexpr size_t WS_CTL = 0;
constexpr size_t WS_STATS = 1 * MiB;
constexpr size_t WS_WIN = 2 * MiB;
constexpr size_t WS_WSB = 20 * MiB, WS_WCV = 22 * MiB, WS_WOUT = 24 * MiB;
constexpr size_t WS_K = 32 * MiB, WS_V = 96 * MiB, WS_SZSB = 160 * MiB, WS_U = 224 * MiB, WS_SZCV = 288 * MiB, WS_SGSB = 352 * MiB, WS_SGCV = 416 * MiB, WS_PART = 480 * MiB, WS_END = 512 * MiB;
constexpr size_t WS_MERGED = WS_K;
constexpr size_t WS_P = WS_V;

constexpr int LDS_BYTES = 147456;
constexpr int BAR_LDS_OFF = 139264;
constexpr int CW_BAR = 4096;
constexpr size_t CTL_ZERO_BYTES = 65536;

#define GAS __attribute__((address_space(1)))
#define LAS __attribute__((address_space(3)))
typedef unsigned short bf16;
typedef unsigned v4u __attribute__((ext_vector_type(4)));
typedef float f32x4 __attribute__((ext_vector_type(4)));
#define LDS_WAIT() asm volatile("s_waitcnt lgkmcnt(0)" ::: "memory")
__device__ __forceinline__ unsigned pk2(float lo, float hi) { return pg8::cvt_pk_bf16(lo, hi); }
__device__ __forceinline__ unsigned f2bf(float f) { return pk2(f, 0.f) & 0xffffu; }
__device__ __forceinline__ float bf2f(unsigned b) { return pg8::bflo(b); }

struct Frame {
    LAS unsigned char* lds;
    int tid, lane, wave, G, bid;
    const float *x, *ln_in_g, *ln_in_b, *w_in, *w_sb, *conv_w, *conv_b, *cln_g, *cln_b, *w_cv, *w_out, *lnp_g, *lnp_b;
    float* out; float* stats;
    bf16 *WIN, *WSB, *WCV, *WOUT, *XN, *ASB, *Q, *K, *V, *SZSB, *U, *SZCV, *SGSB, *SGCV, *MERGED, *P;
};

__device__ __forceinline__ float wave_sum(float v) {
#pragma unroll
    for (int o = 1; o < 64; o <<= 1) v += __shfl_xor(v, o);
    return v;
}
#define XB_TMO      128
#define XB_XCNT(j)  (256  + 64 * (j))
#define XB_XSUB(j)  (1280 + 64 * (j))
#define XB_XGEN(j)  (2304 + 64 * (j))
#define XB_TOP      3328
#define XB_TOPGEN   3392
#define XCD_BAR_WORDS 3456
#define XB_SPIN_CAP (1u << 18)

__device__ __forceinline__ unsigned xb_ld(unsigned* p)              { return __hip_atomic_load(p, __ATOMIC_RELAXED, __HIP_MEMORY_SCOPE_AGENT); }
__device__ __forceinline__ unsigned xb_add(unsigned* p, unsigned v) { return __hip_atomic_fetch_add(p, v, __ATOMIC_RELAXED, __HIP_MEMORY_SCOPE_AGENT); }
__device__ __forceinline__ unsigned xb_xcc_id() { return (unsigned)__builtin_amdgcn_s_getreg((3 << 11) | 20) & 0xFu; }
#define XB_SPIN(cond, bar) do { unsigned _sp = 0; while (cond) { __builtin_amdgcn_s_sleep(1); \
    if ((++_sp & 255u) == 0u) { if (xb_ld(&(bar)[XB_TMO])) break; if (_sp > XB_SPIN_CAP) { atomicAdd(&(bar)[XB_TMO], 1u); break; } } } } while (0)

struct XcdBarrier {
    unsigned* bar; unsigned x;
    volatile LAS unsigned* st;
};

__device__ __forceinline__ XcdBarrier xcd_barrier_post(unsigned* bar, volatile LAS unsigned* st) {
    XcdBarrier b; b.bar = bar; b.x = xb_xcc_id(); b.st = st;
    if (threadIdx.x == 0) (void)xb_add(&bar[XB_XCNT(b.x)], 1u);
    return b;
}
__device__ __forceinline__ void xcd_barrier_complete(unsigned* bar, unsigned x, unsigned& nloc, unsigned& nx) {
    const unsigned G = gridDim.x * gridDim.y * gridDim.z;
    unsigned sum, cnt, mine, sp = 0u;
    for (;;) {
        sum = 0u; cnt = 0u; mine = 0u;
#pragma unroll
        for (unsigned j = 0; j < 16; ++j) { const unsigned c = xb_ld(&bar[XB_XCNT(j)]); sum += c; cnt += (c > 0u) ? 1u : 0u; mine = (j == x) ? c : mine; }
        if (sum == G) break;
        __builtin_amdgcn_s_sleep(1);
        if ((++sp & 255u) == 0u) { if (xb_ld(&bar[XB_TMO])) break; if (sp > XB_SPIN_CAP) { atomicAdd(&bar[XB_TMO], 1u); break; } }
    }
    nloc = mine > 0u ? mine : 1u; nx = cnt > 0u ? cnt : 1u;
}

__device__ __forceinline__ void xcd_barrier(const XcdBarrier& b) {
    asm volatile("s_waitcnt vmcnt(0)" ::: "memory");
    __syncthreads();
    if (threadIdx.x == 0) {
        unsigned* bar = b.bar;
        __builtin_amdgcn_s_waitcnt(0);
        unsigned nloc = b.st[0], nx = b.st[1];
        if (nloc == 0u) { xcd_barrier_complete(bar, b.x, nloc, nx); b.st[0] = nloc; b.st[1] = nx; }
        const unsigned old = xb_add(&bar[XB_XSUB(b.x)], 1u);
        const unsigned gen = old / nloc;
        if (old + 1u == (gen + 1u) * nloc) {
            __builtin_amdgcn_fence(__ATOMIC_RELEASE, "agent");
            asm volatile("s_waitcnt vmcnt(0)" ::: "memory");
            const unsigned og = xb_add(&bar[XB_TOP], 1u);
            const unsigned tg = og / nx;
            if (og + 1u == (tg + 1u) * nx) xb_add(&bar[XB_TOPGEN], 1u);
            else XB_SPIN(xb_ld(&bar[XB_TOPGEN]) == tg, bar);
            __builtin_amdgcn_fence(__ATOMIC_ACQUIRE, "agent");
            xb_add(&bar[XB_XGEN(b.x)], 1u);
            asm volatile("s_waitcnt vmcnt(0)" ::: "memory");
        } else {
            XB_SPIN(xb_ld(&bar[XB_XGEN(b.x)]) == gen, bar);
            __builtin_amdgcn_fence(__ATOMIC_ACQUIRE, "agent");
            asm volatile("s_waitcnt vmcnt(0)" ::: "memory");
        }
    }
    __syncthreads();
}

__device__ __forceinline__ void p0_transpose_item(const float* W, int K, int N, bf16* WT, int dst_row0, int src_col0, int kb, LAS float* scr, int lane) {
    const int k0 = 64 * kb;
#pragma unroll 8
    for (int i = 0; i < 32; ++i) { const int kk = 2 * i + (lane >> 5); scr[kk * 33 + (lane & 31)] = W[(size_t)(k0 + kk) * N + src_col0 + (lane & 31)]; }
    LDS_WAIT(); asm volatile("" ::: "memory");
    const int c = lane & 7;
#pragma unroll
    for (int j = 0; j < 4; ++j) { const int n = (lane >> 3) + 8 * j; const LAS float* s = scr + (8 * c) * 33 + n;
        v4u o; o.x = pk2(s[0 * 33], s[1 * 33]); o.y = pk2(s[2 * 33], s[3 * 33]); o.z = pk2(s[4 * 33], s[5 * 33]); o.w = pk2(s[6 * 33], s[7 * 33]);
        *(GAS v4u*)(WT + (size_t)(dst_row0 + n) * K + k0 + 8 * c) = o; }
    LDS_WAIT(); asm volatile("" ::: "memory");
}
__device__ __forceinline__ int win_src_col(int n) {
    if (n < 4096 || n >= 6144) return n;
    const int r = n - 4096, j = r >> 8, q = r & 255;
    return q < 128 ? 4096 + 128 * j + q : 5120 + 128 * j + (q - 128);
}
__device__ __forceinline__ void p0_prologue(Frame& F) {
    LAS float* scr = (LAS float*)(F.lds + F.wave * 16384);
    const int gw = F.bid * NWAVES + F.wave, NGW = F.G * NWAVES;
    constexpr int I_IN = (D / 64) * (NIN / 32), I_SQ = (D / 64) * (D / 32);
    for (int it = gw; it < I_IN + 3 * I_SQ; it += NGW) {
        int r = it;
        if (r < I_IN) { const int kb = r / (NIN / 32), nb = r % (NIN / 32); p0_transpose_item(F.w_in, D, NIN, F.WIN, 32 * nb, win_src_col(32 * nb), kb, scr, F.lane); continue; } r -= I_IN;
        if (r < I_SQ) { p0_transpose_item(F.w_sb, D, D, F.WSB, 32 * (r % (D / 32)), 32 * (r % (D / 32)), r / (D / 32), scr, F.lane); continue; } r -= I_SQ;
        if (r < I_SQ) { p0_transpose_item(F.w_cv, D, D, F.WCV, 32 * (r % (D / 32)), 32 * (r % (D / 32)), r / (D / 32), scr, F.lane); continue; } r -= I_SQ;
        p0_transpose_item(F.w_out, D, D, F.WOUT, 32 * (r % (D / 32)), 32 * (r % (D / 32)), r / (D / 32), scr, F.lane);
    }
    for (int m = gw; m < M; m += NGW) {
        const GAS f32x4* xr = (const GAS f32x4*)(F.x + (size_t)m * D) + F.lane;
        f32x4 v[4]; float s = 0.f;
#pragma unroll
        for (int j = 0; j < 4; ++j) { v[j] = xr[64 * j]; s += (v[j].x + v[j].y) + (v[j].z + v[j].w); }
        const float mean = wave_sum(s) * (1.f / D); float s2 = 0.f;
#pragma unroll
        for (int j = 0; j < 4; ++j) { const f32x4 d = v[j] - mean; s2 += (d.x * d.x + d.y * d.y) + (d.z * d.z + d.w * d.w); }
        const float rstd = 1.f / sqrtf(wave_sum(s2) * (1.f / D) + LN_EPS);
        if (F.lane == 0) { F.stats[2 * m] = mean; F.stats[2 * m + 1] = rstd; }
        GAS unsigned long long* o8 = (GAS unsigned long long*)(F.XN + (size_t)m * D) + F.lane;
#pragma unroll
        for (int j = 0; j < 4; ++j) { const f32x4 g = *((const GAS f32x4*)F.ln_in_g + F.lane + 64 * j), b = *((const GAS f32x4*)F.ln_in_b + F.lane + 64 * j);
            const f32x4 y = ((v[j] - mean) * rstd) * g + b;
            o8[64 * j] = (unsigned long long)pk2(y.x, y.y) | ((unsigned long long)pk2(y.z, y.w) << 32); }
    }
}

__device__ __forceinline__ void attn_ref_task(Frame& F, int row, int h) {
    const int lane = F.lane; const int t = row & (SEQ - 1); const int rowb = row - t;
    float qd[64];
    { const GAS v4u* qp = (const GAS v4u*)(F.Q + (size_t)row * D + h * HD);
#pragma unroll
      for (int i = 0; i < 8; ++i) { const v4u w = qp[i]; qd[8 * i + 0] = bf2f(w.x & 0xffffu); qd[8 * i + 1] = bf2f(w.x >> 16); qd[8 * i + 2] = bf2f(w.y & 0xffffu); qd[8 * i + 3] = bf2f(w.y >> 16);
          qd[8 * i + 4] = bf2f(w.z & 0xffffu); qd[8 * i + 5] = bf2f(w.z >> 16); qd[8 * i + 6] = bf2f(w.w & 0xffffu); qd[8 * i + 7] = bf2f(w.w >> 16); } }
    float o = 0.f, carry = 0.f;
    for (int j = (t - 1) >> 6; j >= 0; --j) {
        const int s = 64 * j + lane;
        const GAS v4u* kp = (const GAS v4u*)(F.K + (size_t)(rowb + s) * D + h * HD);
        float xs = 0.f;
#pragma unroll
        for (int i = 0; i < 8; ++i) { const v4u w = kp[i];
            xs += qd[8 * i + 0] * bf2f(w.x & 0xffffu); xs += qd[8 * i + 1] * bf2f(w.x >> 16); xs += qd[8 * i + 2] * bf2f(w.y & 0xffffu); xs += qd[8 * i + 3] * bf2f(w.y >> 16);
            xs += qd[8 * i + 4] * bf2f(w.z & 0xffffu); xs += qd[8 * i + 5] * bf2f(w.z >> 16); xs += qd[8 * i + 6] * bf2f(w.w & 0xffffu); xs += qd[8 * i + 7] * bf2f(w.w >> 16); }
        const bool valid = s < t;
        const float sp = valid ? (fmaxf(xs, 0.f) + __builtin_amdgcn_logf(1.0f + __builtin_amdgcn_exp2f(-fabsf(xs)))) : 0.f;
        float suf = sp;
#pragma unroll
        for (int off = 1; off < 64; off <<= 1) { const float v = __shfl_down(suf, off); if (lane + off < 64) suf += v; }
        const float w = valid ? __builtin_amdgcn_exp2f(xs - (suf + carry)) : 0.f;
        carry += __shfl(suf, 0);
        const GAS bf16* vp = (const GAS bf16*)(F.V + (size_t)(rowb + 64 * j) * D + h * HD + lane);
        for (int i = 0; i < 64; ++i) { const float wi = __shfl(w, i); o += wi * bf2f(vp[(size_t)i * D]); }
    }
    const size_t oo = (size_t)row * D + h * HD + lane;
    const float sz = bf2f(F.SZSB[oo]);
    F.ASB[oo] = (bf16)f2bf(o * sz);
}
__device__ __forceinline__ void attn_ref_phase(Frame& F) {
    const int gw = F.bid * NWAVES + F.wave, NGW = F.G * NWAVES;
    for (int it = gw; it < M * NH; it += NGW) attn_ref_task(F, it >> 4, it & 15);
}

namespace sba {
using f32x16 = __attribute__((ext_vector_type(16))) float;
using bf16x8 = __attribute__((ext_vector_type(8))) short;
using s16x4 = __attribute__((ext_vector_type(4))) short;
typedef short v4i16_t __attribute__((ext_vector_type(4)));
constexpr int VDH = 4160;
constexpr int WBYTES = 8448;
constexpr float ATT_EXIT = 1.0e-9f;

__device__ __forceinline__ unsigned cvtpk(float lo, float hi) { return pg8::cvt_pk_bf16(lo, hi); }
#if USE_F16
__device__ __forceinline__ f32x16 mfma32(bf16x8 a, bf16x8 b, f32x16 c) { return __builtin_amdgcn_mfma_f32_32x32x16_f16(__builtin_bit_cast(pg8::h16x8, a), __builtin_bit_cast(pg8::h16x8, b), c, 0, 0, 0); }
#else
__device__ __forceinline__ f32x16 mfma32(bf16x8 a, bf16x8 b, f32x16 c) { return __builtin_amdgcn_mfma_f32_32x32x16_bf16(a, b, c, 0, 0, 0); }
#endif
__device__ __forceinline__ s16x4 vtr(LAS unsigned char* p) { return __builtin_bit_cast(s16x4, __builtin_amdgcn_ds_read_tr16_b64_v4i16((LAS v4i16_t*)p)); }

template <bool MASK>
__device__ __forceinline__ void tile_weights(const f32x16& p0, const f32x16& p1, float (&w)[32], float& carry, int kv0, int start, int r32, int hi) {
    float e[32], c[32], G[8];
    const int hiLim = r32 - kv0 - 4 * hi, loLim = -start - 4 * hi;
#pragma unroll
    for (int idx = 0; idx < 32; ++idx) { const int kvc = (idx >= 16 ? 32 : 0) + (idx & 3) + 8 * ((idx & 15) >> 2);
        float xv = fminf(idx < 16 ? p0[idx] : p1[idx - 16], 64.f);
        if (MASK) xv = (kvc < hiLim && kvc >= loLim) ? xv : -1000.f;
        e[idx] = __builtin_amdgcn_exp2f(xv); }
#pragma unroll
    for (int g = 0; g < 8; ++g) {
        float s = 1.f;
#pragma unroll
        for (int k = 3; k >= 0; --k) { const int idx = 4 * g + k; const float r = __builtin_amdgcn_rcpf(1.0f + e[idx]); s = (k == 3) ? r : s * r; c[idx] = s; }
        G[g] = s;
    }
    float run = carry;
#pragma unroll
    for (int g = 7; g >= 0; --g) {
        const auto rr = __builtin_amdgcn_permlane32_swap(__float_as_uint(G[g]), __float_as_uint(G[g]), false, false);
        const float ev = __uint_as_float(rr[0]), od = __uint_as_float(rr[1]);
        const float tmp = run * od; const float off = hi ? run : tmp; run = tmp * ev;
#pragma unroll
        for (int k = 0; k < 4; ++k) { const int idx = 4 * g + k; w[idx] = e[idx] * (off * c[idx]); }
    }
    carry = run;
}

__device__ __forceinline__ void attn_task(Frame& F, int b, int h, int qblk, LAS unsigned char* vl) {
    const int lane = F.lane, r32 = lane & 31, hi = lane >> 5;
    const int tw = 32 * qblk; const size_t rowb = (size_t)b * SEQ;
    const bf16* Qw = F.Q + (rowb + tw) * D + h * HD;
    const bf16* Kh = F.K + rowb * D + h * HD + hi * 8; const bf16* Vh = F.V + rowb * D + h * HD + (lane & 7) * 8;
    bf16x8 qr[4];
#pragma unroll
    for (int d0 = 0; d0 < 4; ++d0) qr[d0] = *(const GAS bf16x8*)(Qw + (size_t)r32 * D + d0 * 16 + hi * 8);
    f32x16 o[2]; o[0] = f32x16{}; o[1] = f32x16{};
    float carry = 1.f;
    LAS unsigned char* vwr = vl + ((lane & 7) >> 2) * VDH + (lane >> 3) * 64 + (lane & 3) * 16;
    LAS unsigned char* vrd = vl + ((lane >> 4) & 1) * 32 + (lane & 3) * 8 + (4 * hi + ((lane & 15) >> 2)) * 64;
    bf16x8 kf[2][4]; v4u vr[8];
#define SBA_LOAD(st) do { \
        _Pragma("unroll") for (int hh = 0; hh < 2; ++hh) { int kr = (st) + 32 * hh + r32; kr = kr < 0 ? 0 : kr; \
            _Pragma("unroll") for (int d0 = 0; d0 < 4; ++d0) kf[hh][d0] = *(const GAS bf16x8*)(Kh + (size_t)kr * D + d0 * 16); } \
        _Pragma("unroll") for (int it = 0; it < 8; ++it) { int vrw = (st) + 8 * it + (lane >> 3); vrw = vrw < 0 ? 0 : vrw; vr[it] = *(const GAS v4u*)(Vh + (size_t)vrw * D); } } while (0)
    SBA_LOAD(tw - 32);
    for (int i = 0;; ++i) {
        const int start = tw - 32 - 64 * i;
        f32x16 p0 = f32x16{}, p1 = f32x16{};
#pragma unroll
        for (int d0 = 0; d0 < 4; ++d0) { p0 = mfma32(kf[0][d0], qr[d0], p0); p1 = mfma32(kf[1][d0], qr[d0], p1); }
#pragma unroll
        for (int it = 0; it < 8; ++it) *(LAS v4u*)(vwr + it * 512) = vr[it];
        SBA_LOAD(start - 64);
        float w[32];
        if (i == 0 || start < 0) tile_weights<true>(p0, p1, w, carry, start - tw, start, r32, hi);
        else tile_weights<false>(p0, p1, w, carry, start - tw, start, r32, hi);
        bf16x8 pa[4];
#pragma unroll
        for (int ks = 0; ks < 4; ++ks) { v4u t; t.x = cvtpk(w[8 * ks + 0], w[8 * ks + 1]); t.y = cvtpk(w[8 * ks + 2], w[8 * ks + 3]); t.z = cvtpk(w[8 * ks + 4], w[8 * ks + 5]); t.w = cvtpk(w[8 * ks + 6], w[8 * ks + 7]); pa[ks] = __builtin_bit_cast(bf16x8, t); }
#pragma unroll
        for (int d0 = 0; d0 < 2; ++d0)
#pragma unroll
            for (int ks = 0; ks < 4; ++ks) { const s16x4 lo = vtr(vrd + d0 * VDH + ks * 1024), hi4 = vtr(vrd + d0 * VDH + ks * 1024 + 512);
                const bf16x8 vf = (bf16x8){lo[0], lo[1], lo[2], lo[3], hi4[0], hi4[1], hi4[2], hi4[3]};
                o[d0] = mfma32(pa[ks], vf, o[d0]); }
        if (start - 64 <= -64 || __all(carry < ATT_EXIT)) break;
    }
#undef SBA_LOAD
    LAS float* stg = (LAS float*)vl;
#pragma unroll
    for (int r = 0; r < 16; ++r) { const int q = (r & 3) + 8 * (r >> 2) + 4 * hi;
#pragma unroll
        for (int d0 = 0; d0 < 2; ++d0) stg[q * 64 + d0 * 32 + r32] = o[d0][r]; }
    const bf16* Zw = F.SZSB + (rowb + tw) * D + h * HD; bf16* Ow = F.ASB + (rowb + tw) * D + h * HD;
#pragma unroll
    for (int it = 0; it < 4; ++it) { const int row = it * 8 + (lane >> 3), ch = lane & 7;
        const f32x4 a0 = *(const LAS f32x4*)(stg + row * 64 + ch * 8), a1 = *(const LAS f32x4*)(stg + row * 64 + ch * 8 + 4);
        pg8::f32x4 z0, z1; pg8::unpack8(*(const GAS pg8::u32x4*)(Zw + (size_t)row * D + ch * 8), z0, z1);
        *(GAS pg8::u32x4*)(Ow + (size_t)row * D + ch * 8) = pg8::pack8(a0 * z0, a1 * z1); }
}
__device__ __forceinline__ void attn_phase(Frame& F) {
    LAS unsigned char* vl = F.lds + F.wave * WBYTES;
    for (int it = 0;; ++it) {
        const int tsk = (it * F.G + F.bid) * NWAVES + F.wave;
        if (tsk >= NB * NH * (SEQ / 32)) break;
        const int bh = tsk >> 6, qblk = tsk & 63;
        attn_task(F, bh >> 4, bh & 15, qblk, vl);
    }
}
}

typedef float f32x2 __attribute__((ext_vector_type(2)));
__device__ __forceinline__ float dppf(float v, const int ctrl_unused) { return v; }
#define DPP_ADD(v, ctrl) ((v) + __builtin_bit_cast(float, __builtin_amdgcn_update_dpp(0, __builtin_bit_cast(int, (v)), (ctrl), 0xF, 0xF, true)))
__device__ __forceinline__ float row_allsum(float v) {
    v = DPP_ADD(v, 0xB1); v = DPP_ADD(v, 0x4E); v = DPP_ADD(v, 0x124); v = DPP_ADD(v, 0x128); return v;
}
__device__ __forceinline__ void conv_phase(Frame& F, const int dry = 0) {
    const int tid = F.tid, c = 2 * tid, lane = F.lane;
    f32x2 wv[CVK];
#pragma unroll
    for (int k = 0; k < CVK; ++k) wv[k] = *(const GAS f32x2*)(F.conv_w + k * D + c);
    const f32x2 cb = *(const GAS f32x2*)(F.conv_b + c), lg = *(const GAS f32x2*)(F.cln_g + c), lb = *(const GAS f32x2*)(F.cln_b + c);
    LAS float* red = (LAS float*)(F.lds + 69632);
    const int li = lane & 15, R = lane >> 4;
    for (int tile = F.bid; tile < M / 128; tile += F.G) {
        const int t0 = tile * 128;
        const GAS unsigned* Up = (const GAS unsigned*)(F.U + (size_t)t0 * D + c);
        GAS unsigned* Zp = (GAS unsigned*)(F.SZCV + (size_t)t0 * D + c);
        f32x2 ring[32];
        const bool has_hist = (t0 & (SEQ - 1)) != 0;
#pragma unroll
        for (int r = 2; r < 32; ++r) { unsigned w = 0u; if (has_hist) w = Up[(r - 32) * (D / 2)]; ring[r] = (f32x2){bf2f(w & 0xffffu), bf2f(w >> 16)}; }
        ring[0] = (f32x2){0.f, 0.f}; ring[1] = (f32x2){0.f, 0.f};
        unsigned pre[8], zpre[8];
#pragma unroll
        for (int e = 0; e < 8; ++e) { pre[e] = Up[e * (D / 2)]; zpre[e] = Zp[e * (D / 2)]; }
        for (int blk = 0; blk < 4; ++blk) {
#pragma unroll
            for (int g = 0; g < 4; ++g) {
                const int rb = 32 * blk + 8 * g;
                unsigned cur[8], zc[8];
#pragma unroll
                for (int e = 0; e < 8; ++e) { cur[e] = pre[e]; zc[e] = zpre[e]; }
#pragma unroll
                for (int e = 0; e < 8; ++e) { pre[e] = Up[(rb + 8 + e) * (D / 2)]; zpre[e] = Zp[(rb + 8 + e) * (D / 2)]; }
                f32x2 y[8]; float st[16];
#pragma unroll
                for (int e = 0; e < 8; ++e) { const int j = 8 * g + e;
                    ring[j] = (f32x2){bf2f(cur[e] & 0xffffu), bf2f(cur[e] >> 16)};
                    f32x2 a = cb;
#pragma unroll
                    for (int k = 0; k < CVK; ++k) a += wv[k] * ring[(j + 2 + k) & 31];
                    y[e] = a; st[2 * e] = a.x + a.y; st[2 * e + 1] = a.x * a.x + a.y * a.y; }
                float a8[8], b4[4];
#pragma unroll
                for (int i = 0; i < 8; ++i) { const auto rr = __builtin_amdgcn_permlane32_swap(__float_as_uint(st[i]), __float_as_uint(st[i + 8]), false, false); a8[i] = __uint_as_float(rr[0]) + __uint_as_float(rr[1]); }
#pragma unroll
                for (int i = 0; i < 4; ++i) { const auto rr = __builtin_amdgcn_permlane16_swap(__float_as_uint(a8[i]), __float_as_uint(a8[i + 4]), false, false); b4[i] = row_allsum(__uint_as_float(rr[0]) + __uint_as_float(rr[1])); }
                LAS float* rp = red + (g & 1) * 128;
                { const float val = li == 0 ? b4[0] : li == 1 ? b4[1] : li == 2 ? b4[2] : b4[3]; if (li < 4) rp[(4 * R + li) * 8 + F.wave] = val; }
                __syncthreads();
                float tot = 0.f;
                if (lane < 16) { const f32x4 p = *(const LAS f32x4*)(rp + lane * 8), q = *(const LAS f32x4*)(rp + lane * 8 + 4); tot = ((p.x + p.y) + (p.z + p.w)) + ((q.x + q.y) + (q.z + q.w)); }
#pragma unroll
                for (int e = 0; e < 8; ++e) {
                    const float s1 = __builtin_amdgcn_readlane(tot, 2 * e), s2 = __builtin_amdgcn_readlane(tot, 2 * e + 1);
                    const float mean = s1 * (1.f / D), var = fmaxf(s2 * (1.f / D) - mean * mean, 0.f);
                    const float rstd = 1.f / sqrtf(var + LN_EPS);
                    const f32x2 yn = ((y[e] - mean) * rstd) * lg + lb;
                    const unsigned res = pk2(yn.x * pg8::sigmoidf_(yn.x) * bf2f(zc[e] & 0xffffu), yn.y * pg8::sigmoidf_(yn.y) * bf2f(zc[e] >> 16));
                    if (!dry) Zp[(rb + e) * (D / 2)] = res; }
            }
        }
    }
}

__device__ __forceinline__ void lnpost_phase(Frame& F, const int dry = 0) {
    const int gw = F.bid * NWAVES + F.wave, NGW = F.G * NWAVES;
    for (int m = gw; m < M; m += NGW) {
        GAS f32x4* xr = (GAS f32x4*)(F.out + (size_t)m * D) + F.lane;
        f32x4 v[4]; float s = 0.f;
#pragma unroll
        for (int j = 0; j < 4; ++j) { v[j] = xr[64 * j]; s += (v[j].x + v[j].y) + (v[j].z + v[j].w); }
        const float mean = wave_sum(s) * (1.f / D); float s2 = 0.f;
#pragma unroll
        for (int j = 0; j < 4; ++j) { v[j] = v[j] - mean; s2 += (v[j].x * v[j].x + v[j].y * v[j].y) + (v[j].z * v[j].z + v[j].w * v[j].w); }
        const float rstd = 1.f / sqrtf(wave_sum(s2) * (1.f / D) + LN_EPS);
#pragma unroll
        for (int j = 0; j < 4; ++j) { const f32x4 g = *((const GAS f32x4*)F.lnp_g + F.lane + 64 * j), b = *((const GAS f32x4*)F.lnp_b + F.lane + 64 * j); const f32x4 res = (v[j] * rstd) * g + b; if (!dry) xr[64 * j] = res; }
    }
}

#ifndef P1_STAGGER
#define P1_STAGGER 0
#endif
#ifndef PROBE_DRY_ALL
#define PROBE_DRY_ALL 1
#endif
struct Args { const float* in[13]; float* out; unsigned char* ws; int ph_lo, ph_hi, fused, dry, li, pad; };
constexpr int NPHASE = 8;
__global__ void __launch_bounds__(NWAVES * 64, 2) fwd_kernel(Args args) {
    extern __shared__ __attribute__((aligned(16))) unsigned char lds[];
    Frame F;
    F.lds = (LAS unsigned char*)lds;
    F.tid = threadIdx.x; F.lane = F.tid & 63; F.wave = __builtin_amdgcn_readfirstlane(F.tid >> 6); F.G = gridDim.x; F.bid = blockIdx.x;
    unsigned char* ws = args.ws;
    F.x = args.in[0]; F.ln_in_g = args.in[1]; F.ln_in_b = args.in[2]; F.w_in = args.in[3]; F.w_sb = args.in[4]; F.conv_w = args.in[5]; F.conv_b = args.in[6];
    F.cln_g = args.in[7]; F.cln_b = args.in[8]; F.w_cv = args.in[9]; F.w_out = args.in[10]; F.lnp_g = args.in[11]; F.lnp_b = args.in[12];
    F.out = args.out; F.stats = (float*)(ws + WS_STATS);
    F.WIN = (bf16*)(ws + WS_WIN); F.WSB = (bf16*)(ws + WS_WSB); F.WCV = (bf16*)(ws + WS_WCV); F.WOUT = (bf16*)(ws + WS_WOUT);
    F.XN = (bf16*)args.out; F.ASB = (bf16*)args.out; F.Q = (bf16*)args.out + (size_t)M * D;
    F.K = (bf16*)(ws + WS_K); F.V = (bf16*)(ws + WS_V); F.SZSB = (bf16*)(ws + WS_SZSB); F.U = (bf16*)(ws + WS_U); F.SZCV = (bf16*)(ws + WS_SZCV);
    F.SGSB = (bf16*)(ws + WS_SGSB); F.SGCV = (bf16*)(ws + WS_SGCV); F.MERGED = (bf16*)(ws + WS_MERGED); F.P = (bf16*)(ws + WS_P);
    const int lo = args.ph_lo, hi = args.ph_hi; const bool fused = args.fused != 0;
    volatile LAS unsigned* bst = (volatile LAS unsigned*)(F.lds + BAR_LDS_OFF);
    if (F.tid < 2) bst[F.tid] = 0u;
    __syncthreads();
    XcdBarrier bar; bar.bar = (unsigned*)(ws + WS_CTL) + CW_BAR + args.li * XCD_BAR_WORDS; bar.x = 0; bar.st = nullptr;
    if (fused) bar = xcd_barrier_post((unsigned*)(ws + WS_CTL) + CW_BAR + args.li * XCD_BAR_WORDS, bst);
#define IN(k) (lo <= (k) && (k) < hi)
#if defined(USE_CG_SYNC)
#define SEAM(k) do { if (fused && IN(k) && IN((k) + 1)) { cg::this_grid().sync(); } } while (0)
#else
#define SEAM(k) do { if (fused && IN(k) && IN((k) + 1)) { xcd_barrier(bar); } } while (0)
#endif

    if (IN(0)) { p0_prologue(F); } SEAM(0);
    if (IN(1)) {
        pg8::Gemm g{F.XN, F.WIN, M, NIN, D}; pg8::StaggerOrder S; S.init2(M, NIN, F.G, F.bid, (P1_STAGGER && F.G == 256) ? (F.bid & 1) : 0);
        pg8::f32x4* part = (pg8::f32x4*)(ws + WS_PART) + (size_t)(F.bid >> 1) * (65536 / 4);
        pg8::EpiIn E{F.Q, F.K, F.V, F.SZSB, F.U, F.SZCV, F.SGSB, F.SGCV, (args.dry & 2) && (PROBE_DRY_ALL || ((F.bid >> 3) & 1))};
        pg8::gemm_phase<pg8::EpiIn, pg8::StaggerOrder, true, true>(F.lds, g, S, E, part);
    } SEAM(1);
    #if defined(ATTN_REF)
    if (IN(2)) { attn_ref_phase(F); }
    if (IN(3)) { conv_phase(F, args.dry & 8); } SEAM(3);
#else
    if (IN(2)) { sba::attn_phase(F); }
    if (IN(3)) { conv_phase(F, args.dry & 8); } SEAM(3);
#endif
    if (IN(4)) {
        pg8::Gemm g{F.ASB, F.WSB, M, D, D}; pg8::StaticOrder S; S.init(M, D, F.G, F.bid);
        pg8::EpiGate E{F.SGSB, F.P};
        pg8::gemm_phase<pg8::EpiGate, pg8::StaticOrder, true, true>(F.lds, g, S, E);
    } SEAM(4);
    if (IN(5)) {
        pg8::Gemm g{F.SZCV, F.WCV, M, D, D}; pg8::StaticOrder S; S.init(M, D, F.G, F.bid);
        pg8::EpiGateAdd E{F.SGCV, F.P, F.MERGED};
        pg8::gemm_phase<pg8::EpiGateAdd, pg8::StaticOrder, true, true>(F.lds, g, S, E);
    } SEAM(5);
    if (IN(6)) {
        pg8::Gemm g{F.MERGED, F.WOUT, M, D, D}; pg8::StaticOrder S; S.init(M, D, F.G, F.bid);
        pg8::EpiOut E{F.x, F.stats, F.ln_in_g, F.ln_in_b, F.out, DN_ALPHA};
        pg8::gemm_phase<pg8::EpiOut, pg8::StaticOrder, true, true>(F.lds, g, S, E);
    } SEAM(6);
    if (IN(7)) { lnpost_phase(F, args.dry & 128); }
#undef IN
#undef SEAM
}

#ifndef MK_N_LAUNCHES
#define MK_N_LAUNCHES 1
#endif
extern "C" void kernel_launch(void* const* d_in, const int* in_sizes, int n_in, void* d_out, int out_size, void* d_ws, size_t ws_size, hipStream_t stream) {
    static int grid = 0;
    if (grid == 0) {
        if (n_in != 13 || in_sizes[0] != M * D || out_size != M * D || ws_size < WS_END) { fprintf(stderr, "kernel_launch: unexpected shapes (n_in %d, in0 %d, out %d, ws %zu); nothing launched\n", n_in, n_in > 0 ? in_sizes[0] : -1, out_size, ws_size); grid = -1; return; }
        int dev = 0, cus = 0, per_cu = 0;
        if (hipGetDevice(&dev) != hipSuccess || hipDeviceGetAttribute(&cus, hipDeviceAttributeMultiprocessorCount, dev) != hipSuccess) { grid = -1; return; }
        if (hipFuncSetAttribute((const void*)fwd_kernel, hipFuncAttributeMaxDynamicSharedMemorySize, LDS_BYTES) != hipSuccess) { fprintf(stderr, "kernel_launch: hipFuncSetAttribute failed\n"); grid = -1; return; }
        if (hipOccupancyMaxActiveBlocksPerMultiprocessor(&per_cu, (const void*)fwd_kernel, NWAVES * 64, LDS_BYTES) != hipSuccess || per_cu < 1) { fprintf(stderr, "kernel_launch: occupancy query says %d blocks per CU\n", per_cu); (void)hipGetLastError(); grid = -1; return; }
        grid = cus * (per_cu < 1 ? 1 : 1);
    }
    if (grid < 0) return;
    if (hipMemsetAsync((char*)d_ws + WS_CTL, 0, CTL_ZERO_BYTES, stream) != hipSuccess) { fprintf(stderr, "kernel_launch: hipMemsetAsync failed\n"); return; }
    Args a{};
    for (int i = 0; i < 13; ++i) a.in[i] = (const float*)d_in[i];
    a.out = (float*)d_out; a.ws = (unsigned char*)d_ws;
#if defined(PROBE_SPLIT)
    for (int li = 0; li < 2; ++li) {
        a.ph_lo = li == 0 ? 0 : PROBE_SPLIT; a.ph_hi = li == 0 ? PROBE_SPLIT + 1 : NPHASE; a.fused = 1; a.li = li;
#if defined(PROBE_DRY)
        a.dry = li == 0 ? (1 << PROBE_SPLIT) : 0;
#endif
        void* kargs[] = {&a};
        hipError_t e = hipLaunchCooperativeKernel((const void*)fwd_kernel, dim3(grid), dim3(NWAVES * 64), kargs, LDS_BYTES, stream);
        if (e != hipSuccess) fprintf(stderr, "kernel_launch: cooperative launch failed: %s (grid %d)\n", hipGetErrorString(e), grid);
    }
#else
    if (MK_N_LAUNCHES == 1) {
        a.ph_lo = 0; a.ph_hi = NPHASE; a.fused = 1;
        void* kargs[] = {&a};
        hipError_t e = hipLaunchCooperativeKernel((const void*)fwd_kernel, dim3(grid), dim3(NWAVES * 64), kargs, LDS_BYTES, stream);
        if (e != hipSuccess) fprintf(stderr, "kernel_launch: cooperative launch failed: %s (grid %d)\n", hipGetErrorString(e), grid);
    } else {
        for (int ph = 0; ph < NPHASE; ++ph) {
            a.ph_lo = ph; a.ph_hi = ph + 1; a.fused = 0;
            hipLaunchKernelGGL(fwd_kernel, dim3(grid), dim3(NWAVES * 64), LDS_BYTES, stream, a);
        }
    }
#endif
}
```

```cpp
#include <hip/hip_runtime.h>
#include <hip/hip_cooperative_groups.h>
#include <cstdio>
#include <cstdint>
namespace cg = cooperative_groups;

namespace pg8 {
#define PG8_LAS __attribute__((address_space(3)))
typedef unsigned short bf16_t;
typedef short bf16x8 __attribute__((ext_vector_type(8)));
typedef float f32x4 __attribute__((ext_vector_type(4)));
typedef unsigned u32x4 __attribute__((ext_vector_type(4)));
constexpr int BM = 256, BK = 64, HALF = 128, HTB = HALF * BK * 2  , STAGE_BYTES = 8 * HTB, NXCD = 8, WGM = 8;

__host__ __device__ __forceinline__ int lds_byte(int r, int c) { const int st = (r >> 4) * 2 + (c >> 5), rr = r & 15, cc = c & 31, ob = rr * 64 + cc * 2; return st * 1024 + (ob ^ (((ob >> 9) & 1) << 5)); }
__host__ __device__ __forceinline__ void stage_rc(int b, int& R, int& C) { const int st = b / 1024, sb = b % 1024, swz = sb ^ (((sb >> 9) & 1) << 5); R = (st >> 1) * 16 + swz / 64; C = (st & 1) * 32 + (swz % 64) / 2; }
__host__ __device__ __forceinline__ int perm32(int rho) { const int n = rho >> 4, i = rho & 15; return 8 * (i >> 2) + 4 * n + (i & 3); }

struct Unit { int pm, pn, kt0, nkt, mode; };
struct Gemm { const bf16_t* A; const bf16_t* Bt; int M, N, K; };

struct StaticOrder {
    int nM, nN, nwg, G, c, nkt;
    __host__ __device__ void init(int M, int N, int G_, int c_, int K = 1024) { nM = M / BM; nN = N / BM; nwg = nM * nN; G = G_; c = c_; nkt = K / BK; }
    __host__ __device__ bool next(int i, Unit& u) const {
        const long L = (long)i * G + c; if (L >= nwg) return false;
        int wgid = (int)L; { const int q = nwg / NXCD, r = nwg % NXCD, xcd = wgid % NXCD, off = wgid / NXCD; wgid = (xcd < r ? xcd * (q + 1) : r * (q + 1) + (xcd - r) * q) + off; }
        const int nig = WGM * nN, gid = wgid / nig, fm = gid * WGM, gsz = (nM - fm) < WGM ? (nM - fm) : WGM;
        u.pm = fm + ((wgid % nig) % gsz); u.pn = (wgid % nig) / gsz; u.kt0 = 0; u.nkt = nkt; u.mode = 0; return true;
    }
    __device__ __forceinline__ void a_ready(const Unit&) const {}
    __device__ __forceinline__ void done(const Unit&) const {}
};

struct StaggerOrder : StaticOrder {
    int stag, n;
    __host__ __device__ void init2(int M, int N, int G_, int c_, int stag_, int K = 1024) { init(M, N, G_, c_, K); stag = stag_; n = (nwg - c + G - 1) / G; if (n < 2 || (nkt & 3)) stag = 0; }
    __host__ __device__ bool next(int i, Unit& u) const {
        if (!stag) return StaticOrder::next(i, u);
        if (i > n) return false;
        if (i == 0) { StaticOrder::next(0, u); u.nkt = nkt / 2; u.mode = 1; return true; }
        if (i == n) { StaticOrder::next(0, u); u.kt0 = nkt / 2; u.nkt = nkt / 2; u.mode = 2; return true; }
        return StaticOrder::next(i, u);
    }
};

#ifndef USE_F16
#define USE_F16 0
#endif
typedef _Float16 h16x2 __attribute__((ext_vector_type(2)));
typedef _Float16 h16x8 __attribute__((ext_vector_type(8)));
typedef float f32x2p __attribute__((ext_vector_type(2)));
#if USE_F16
__device__ __forceinline__ unsigned cvt_pk_bf16(float lo, float hi) { const f32x2p v = {lo, hi}; return __builtin_bit_cast(unsigned, __builtin_convertvector(v, h16x2)); }
__device__ __forceinline__ float bflo(unsigned w) { return (float)__builtin_bit_cast(h16x2, w)[0]; }
__device__ __forceinline__ float bfhi(unsigned w) { return (float)__builtin_bit_cast(h16x2, w)[1]; }
__device__ __forceinline__ f32x4 mfma16(bf16x8 a, bf16x8 b, f32x4 c) { return __builtin_amdgcn_mfma_f32_16x16x32_f16(__builtin_bit_cast(h16x8, a), __builtin_bit_cast(h16x8, b), c, 0, 0, 0); }
#else
__device__ __forceinline__ unsigned cvt_pk_bf16(float lo, float hi) { unsigned r; asm volatile("v_cvt_pk_bf16_f32 %0, %1, %2" : "=v"(r) : "v"(lo), "v"(hi)); return r; }
__device__ __forceinline__ float bflo(unsigned w) { return __uint_as_float(w << 16); }
__device__ __forceinline__ float bfhi(unsigned w) { return __uint_as_float(w & 0xffff0000u); }
__device__ __forceinline__ f32x4 mfma16(bf16x8 a, bf16x8 b, f32x4 c) { return __builtin_amdgcn_mfma_f32_16x16x32_bf16(a, b, c, 0, 0, 0); }
#endif
__device__ __forceinline__ float sigmoidf_(float x) { return __builtin_amdgcn_rcpf(1.0f + __builtin_amdgcn_exp2f(-1.4426950408889634f * x)); }
__device__ __forceinline__ f32x4 sig4(f32x4 v) { return (f32x4){sigmoidf_(v[0]), sigmoidf_(v[1]), sigmoidf_(v[2]), sigmoidf_(v[3])}; }
__device__ __forceinline__ u32x4 pack8(f32x4 v0, f32x4 v1) { u32x4 w; w.x = cvt_pk_bf16(v0[0], v0[1]); w.y = cvt_pk_bf16(v0[2], v0[3]); w.z = cvt_pk_bf16(v1[0], v1[1]); w.w = cvt_pk_bf16(v1[2], v1[3]); return w; }
__device__ __forceinline__ void unpack8(u32x4 w, f32x4& v0, f32x4& v1) { v0 = (f32x4){bflo(w.x), bfhi(w.x), bflo(w.y), bfhi(w.y)}; v1 = (f32x4){bflo(w.z), bfhi(w.z), bflo(w.w), bfhi(w.w)}; }

#ifndef EPI_STORE_AUX
#define EPI_STORE_AUX 18
#endif
__device__ __forceinline__ void store16f(float* base, unsigned byte_off, f32x4 v) {
#if EPI_STORE_AUX == 0
    *(f32x4*)((char*)base + byte_off) = v;
#else
    __builtin_amdgcn_raw_buffer_store_b128(__builtin_bit_cast(u32x4, v), __builtin_amdgcn_make_buffer_rsrc(base, 0, 0x8000000, 0x00020000), byte_off, 0, EPI_STORE_AUX);
#endif
}
__device__ __forceinline__ void store16(bf16_t* base, unsigned byte_off, u32x4 v) {
#if EPI_STORE_AUX == 0
    *(u32x4*)((char*)base + byte_off) = v;
#else
    __builtin_amdgcn_raw_buffer_store_b128(v, __builtin_amdgcn_make_buffer_rsrc(base, 0, 0x4000000, 0x00020000), byte_off, 0, EPI_STORE_AUX);
#endif
}
constexpr float QSCALE = 0.125f * 1.4426950408889634f;

struct EpiIn {
    static constexpr bool PERM = true, AFTER_DRAIN = false;
    bf16_t *Q, *Kb, *Vb, *SZSB, *U, *SZCV, *SGSB, *SGCV; int dry;
    __device__ __forceinline__ void operator()(const f32x4 (&acc)[2][2][4][2], const Unit& u, int wr, int wc, int fr, int fq) const {
        const int row0 = u.pm * BM + wr * 64 + fr; const int pn = u.pn;
        if (pn >= 16 && pn < 24) {
            const unsigned col = (pn - 16) * 128 + wc * 32 + 8 * fq;
#pragma unroll
            for (int ai = 0; ai < 2; ++ai)
#pragma unroll
                for (int m = 0; m < 4; ++m) { const unsigned off = ((unsigned)(row0 + ai * HALF + m * 16) * 1024u + col) * 2u;
                    const f32x4 v0 = acc[ai][0][m][0] * sig4(acc[ai][1][m][0]), v1 = acc[ai][0][m][1] * sig4(acc[ai][1][m][1]);
                    const u32x4 pk = pack8(v0, v1); if (!dry) store16(U, off, pk); }
            return;
        }
        const int grp = pn >> 2; int mode; bf16_t* base;
        float sc = 1.f;
        if (grp == 0) { base = Q; mode = 0; sc = QSCALE; } else if (grp == 1) { base = Kb; mode = 0; } else if (grp == 2) { base = Vb; mode = 0; }
        else if (grp == 3) { base = SZSB; mode = 1; } else if (grp == 6) { base = SZCV; mode = 1; } else if (grp == 7) { base = SGSB; mode = 2; } else { base = SGCV; mode = 2; }
        const unsigned col = (pn & 3) * BM + wc * 32 + 8 * fq;
#pragma unroll
        for (int ai = 0; ai < 2; ++ai)
#pragma unroll
            for (int m = 0; m < 4; ++m) { const unsigned off = ((unsigned)(row0 + ai * HALF + m * 16) * 1024u + col) * 2u;
#pragma unroll
                for (int bj = 0; bj < 2; ++bj) { f32x4 v0 = acc[ai][bj][m][0], v1 = acc[ai][bj][m][1];
                    if (mode == 0) { v0 = v0 * sc; v1 = v1 * sc; }
                    else if (mode == 1) { v0 = v0 * sig4(v0); v1 = v1 * sig4(v1); }
                    else { v0 = sig4(v0); v1 = sig4(v1); }
                    const u32x4 pk = pack8(v0, v1); if (!dry) store16(base, off + bj * HALF * 2, pk); } }
    }
};
struct EpiGate {
    static constexpr bool PERM = true, AFTER_DRAIN = false;
    const bf16_t* G; bf16_t* P;
    __device__ __forceinline__ void operator()(const f32x4 (&acc)[2][2][4][2], const Unit& u, int wr, int wc, int fr, int fq) const {
        const int row0 = u.pm * BM + wr * 64 + fr, col0 = u.pn * BM + wc * 32 + 8 * fq;
#pragma unroll
        for (int ai = 0; ai < 2; ++ai)
#pragma unroll
            for (int m = 0; m < 4; ++m) { const size_t off = (size_t)(row0 + ai * HALF + m * 16) * 1024 + col0;
#pragma unroll
                for (int bj = 0; bj < 2; ++bj) { f32x4 g0, g1; unpack8(*(const u32x4*)(G + off + bj * HALF), g0, g1);
                    store16(P, (unsigned)(off + bj * HALF) * 2u, pack8(acc[ai][bj][m][0] * g0, acc[ai][bj][m][1] * g1)); } }
    }
};
struct EpiGateAdd {
    static constexpr bool PERM = true, AFTER_DRAIN = false;
    const bf16_t* G; const bf16_t* P; bf16_t* O;
    __device__ __forceinline__ void operator()(const f32x4 (&acc)[2][2][4][2], const Unit& u, int wr, int wc, int fr, int fq) const {
        const int row0 = u.pm * BM + wr * 64 + fr, col0 = u.pn * BM + wc * 32 + 8 * fq;
#pragma unroll
        for (int ai = 0; ai < 2; ++ai)
#pragma unroll
            for (int m = 0; m < 4; ++m) { const size_t off = (size_t)(row0 + ai * HALF + m * 16) * 1024 + col0;
#pragma unroll
                for (int bj = 0; bj < 2; ++bj) { f32x4 g0, g1, p0, p1; unpack8(*(const u32x4*)(G + off + bj * HALF), g0, g1); unpack8(*(const u32x4*)(P + off + bj * HALF), p0, p1);
                    store16(O, (unsigned)(off + bj * HALF) * 2u, pack8(p0 + acc[ai][bj][m][0] * g0, p1 + acc[ai][bj][m][1] * g1)); } }
    }
};
struct EpiOut {
    static constexpr bool PERM = false, AFTER_DRAIN = false;
    const float* x; const float* stats; const float* g; const float* b; float* C; float alpha;
    __device__ __forceinline__ void operator()(const f32x4 (&acc)[2][2][4][2], const Unit& u, int wr, int wc, int fr, int fq) const {
        const int row0 = u.pm * BM + wr * 64 + fr, col0 = u.pn * BM + wc * 32 + 4 * fq;
        f32x4 gv[2][2], bv[2][2];
#pragma unroll
        for (int bj = 0; bj < 2; ++bj)
#pragma unroll
            for (int n = 0; n < 2; ++n) { gv[bj][n] = *(const f32x4*)(g + col0 + bj * HALF + n * 16) * alpha; bv[bj][n] = *(const f32x4*)(b + col0 + bj * HALF + n * 16) * alpha; }
#pragma unroll
        for (int ai = 0; ai < 2; ++ai)
#pragma unroll
            for (int m = 0; m < 4; ++m) { const int row = row0 + ai * HALF + m * 16; const size_t off = (size_t)row * 1024 + col0;
                const float mu = stats[2 * row], rs = stats[2 * row + 1];
#pragma unroll
                for (int bj = 0; bj < 2; ++bj)
#pragma unroll
                    for (int n = 0; n < 2; ++n) { const f32x4 xv = *(const f32x4*)(x + off + bj * HALF + n * 16);
                        store16f(C, (unsigned)(off + bj * HALF + n * 16) * 4u, ((xv - mu) * rs) * gv[bj][n] + bv[bj][n] + acc[ai][bj][m][n]); } }
    }
};

template <class Epi, class Sched, bool ALIGN_EPI = false, bool SP2 = false>
__device__ __forceinline__ void gemm_phase(PG8_LAS unsigned char* lds, const Gemm g, const Sched& S, const Epi& E, f32x4* part = nullptr) {
    const int tid = threadIdx.x, wid = __builtin_amdgcn_readfirstlane(tid >> 6), lane = tid & 63, wr = wid >> 2, wc = wid & 3, fr = lane & 15, fq = lane >> 4;
    const int K = g.K;
    unsigned voffA[2], voffB[2];
#pragma unroll
    for (int i = 0; i < 2; ++i) { int R, C; stage_rc(tid * 16 + i * 8192, R, C); const int Rb = Epi::PERM ? ((R & ~31) + perm32(R & 31)) : R;
        voffA[i] = (unsigned)(R * K + C) * 2u; voffB[i] = (unsigned)(Rb * K + C) * 2u; }
    const size_t kstep = (size_t)(BK * 2);
    const size_t hstep = (size_t)HALF * K * 2;
    const size_t tstep = 2 * hstep;
    const unsigned ldsw = (unsigned)wid * 1024u;
    const int aoff = lds_byte(wr * 64 + fr, fq * 8), boff = lds_byte(wc * 32 + fr, fq * 8);
#define PG8_SA(b, h) (((b) * 2 + (h)) * HTB)
#define PG8_SB(b, h) ((4 + (b) * 2 + (h)) * HTB)
#define PG8_STAGE(bufoff, gbase, voff) do { _Pragma("unroll") for (int _i = 0; _i < 2; ++_i) \
        __builtin_amdgcn_global_load_lds((const unsigned*)((const char*)(gbase) + (voff)[_i]), (PG8_LAS unsigned*)(lds + (bufoff) + ldsw + _i * 8192), 16, 0, 0); } while (0)
#define PG8_LDA(dst, b, h) do { _Pragma("unroll") for (int m = 0; m < 4; ++m) _Pragma("unroll") for (int k = 0; k < 2; ++k) dst[m][k] = *(const PG8_LAS bf16x8*)(lds + PG8_SA(b, h) + aoff + m * 2048 + k * 1024); } while (0)
#define PG8_LDB(dst, b, h) do { _Pragma("unroll") for (int n = 0; n < 2; ++n) _Pragma("unroll") for (int k = 0; k < 2; ++k) dst[n][k] = *(const PG8_LAS bf16x8*)(lds + PG8_SB(b, h) + boff + n * 2048 + k * 1024); } while (0)
#define PG8_MMA(ai, bj, At, Bt) do { __builtin_amdgcn_s_setprio(1); _Pragma("unroll") for (int m = 0; m < 4; ++m) _Pragma("unroll") for (int n = 0; n < 2; ++n) _Pragma("unroll") for (int k = 0; k < 2; ++k) \
        acc[ai][bj][m][n] = mfma16(Bt[n][k], At[m][k], acc[ai][bj][m][n]); __builtin_amdgcn_s_setprio(0); } while (0)
#define PG8_WAIT_V(n) asm volatile("s_waitcnt vmcnt(" #n ")" ::: "memory")
#define PG8_WAIT_L(n) asm volatile("s_waitcnt lgkmcnt(" #n ")" ::: "memory")
#define PG8_BAR __builtin_amdgcn_s_barrier()
#define PG8_SCHED __builtin_amdgcn_sched_barrier(0)
    Unit cur, nxt; int ui = 0;
    if (!S.next(0, cur)) return;
    f32x4 acc[2][2][4][2];
#pragma unroll
    for (int a = 0; a < 2; ++a)
#pragma unroll
        for (int b = 0; b < 2; ++b)
#pragma unroll
            for (int m = 0; m < 4; ++m)
#pragma unroll
                for (int n = 0; n < 2; ++n) acc[a][b][m][n] = (f32x4){0.f, 0.f, 0.f, 0.f};
    bf16x8 At[4][2], B0[2][2], B1[2][2];
    const char* cA = (const char*)g.A + (size_t)cur.pm * tstep + (size_t)cur.kt0 * (BK * 2); const char* cB = (const char*)g.Bt + (size_t)cur.pn * tstep + (size_t)cur.kt0 * (BK * 2);
    S.a_ready(cur);
    if constexpr (SP2) {
        PG8_STAGE(PG8_SB(0, 0), cB, voffB); PG8_STAGE(PG8_SB(0, 1), cB + hstep, voffB); PG8_STAGE(PG8_SA(0, 0), cA, voffA); PG8_STAGE(PG8_SA(0, 1), cA + hstep, voffA);
        if (wr == 1) PG8_BAR;
        PG8_WAIT_V(2); PG8_BAR;
        PG8_STAGE(PG8_SB(1, 0), cB + kstep, voffB); PG8_STAGE(PG8_SA(1, 0), cA + kstep, voffA); PG8_STAGE(PG8_SB(1, 1), cB + hstep + kstep, voffB);
        PG8_WAIT_V(6); PG8_BAR;
    } else {
        PG8_STAGE(PG8_SB(0, 0), cB, voffB); PG8_STAGE(PG8_SA(0, 0), cA, voffA); PG8_STAGE(PG8_SB(0, 1), cB + hstep, voffB); PG8_STAGE(PG8_SA(0, 1), cA + hstep, voffA);
        if (wr == 1) PG8_BAR;
        PG8_WAIT_V(4); PG8_BAR;
        PG8_STAGE(PG8_SB(1, 0), cB + kstep, voffB); PG8_STAGE(PG8_SA(1, 0), cA + kstep, voffA); PG8_STAGE(PG8_SB(1, 1), cB + hstep + kstep, voffB);
        PG8_WAIT_V(6); PG8_BAR;
    }
    for (;;) {
        const bool has_next = S.next(ui + 1, nxt);
        const char* nA = has_next ? (const char*)g.A + (size_t)nxt.pm * tstep + (size_t)nxt.kt0 * (BK * 2) : cA; const char* nB = has_next ? (const char*)g.Bt + (size_t)nxt.pn * tstep + (size_t)nxt.kt0 * (BK * 2) : cB;
        const int nt = cur.nkt;
        for (int t = 0; t < nt; t += 2) {
            const bool last = (t == nt - 2);
            const char* a1 = cA + (size_t)(t + 1) * kstep;
            const char* a2 = last ? nA : cA + (size_t)(t + 2) * kstep; const char* b2 = last ? nB : cB + (size_t)(t + 2) * kstep;
            const char* a3 = a2 + kstep; const char* b3 = b2 + kstep;
            if (last && has_next) S.a_ready(nxt);
            if constexpr (SP2) {
            PG8_LDB(B0, 0, 0); PG8_LDB(B1, 0, 1); PG8_SCHED; PG8_LDA(At, 0, 0); PG8_STAGE(PG8_SA(1, 1), a1 + hstep, voffA);
            PG8_WAIT_V(8); PG8_WAIT_L(0); PG8_BAR; PG8_MMA(0, 0, At, B0); PG8_MMA(0, 1, At, B1); PG8_BAR; PG8_SCHED;
            PG8_LDA(At, 0, 1); PG8_STAGE(PG8_SB(0, 0), b2, voffB); PG8_STAGE(PG8_SB(0, 1), b2 + hstep, voffB); PG8_STAGE(PG8_SA(0, 0), a2, voffA);
            PG8_WAIT_V(8); PG8_WAIT_L(0); PG8_BAR; PG8_MMA(1, 0, At, B0); PG8_MMA(1, 1, At, B1); PG8_BAR; PG8_SCHED;
            PG8_LDB(B0, 1, 0); PG8_LDB(B1, 1, 1); PG8_SCHED; PG8_LDA(At, 1, 0); PG8_STAGE(PG8_SA(0, 1), a2 + hstep, voffA);
            PG8_WAIT_V(8); PG8_WAIT_L(0); PG8_BAR; PG8_MMA(0, 0, At, B0); PG8_MMA(0, 1, At, B1); PG8_BAR; PG8_SCHED;
            PG8_LDA(At, 1, 1); PG8_STAGE(PG8_SB(1, 0), b3, voffB); PG8_STAGE(PG8_SB(1, 1), b3 + hstep, voffB); PG8_STAGE(PG8_SA(1, 0), a3, voffA);
            PG8_WAIT_V(8); PG8_WAIT_L(0); PG8_BAR; PG8_MMA(1, 0, At, B0); PG8_MMA(1, 1, At, B1); PG8_BAR; PG8_SCHED;
            } else {
            PG8_LDB(B0, 0, 0); PG8_SCHED; PG8_LDA(At, 0, 0); PG8_STAGE(PG8_SA(1, 1), a1 + hstep, voffA);
            PG8_WAIT_L(8); PG8_BAR; PG8_WAIT_L(0); PG8_MMA(0, 0, At, B0); PG8_BAR; PG8_SCHED;
            PG8_LDB(B1, 0, 1); PG8_STAGE(PG8_SB(0, 0), b2, voffB);
            PG8_BAR; PG8_WAIT_L(0); PG8_MMA(0, 1, At, B1); PG8_BAR;
            PG8_LDA(At, 0, 1); PG8_STAGE(PG8_SA(0, 0), a2, voffA);
            PG8_BAR; PG8_WAIT_L(0); PG8_MMA(1, 0, At, B0); PG8_BAR; PG8_SCHED;
            PG8_STAGE(PG8_SB(0, 1), b2 + hstep, voffB);
            PG8_WAIT_V(6); PG8_BAR; PG8_MMA(1, 1, At, B1); PG8_BAR;
            PG8_LDB(B0, 1, 0); PG8_SCHED; PG8_LDA(At, 1, 0); PG8_STAGE(PG8_SA(0, 1), a2 + hstep, voffA);
            PG8_WAIT_L(8); PG8_BAR; PG8_WAIT_L(0); PG8_MMA(0, 0, At, B0); PG8_BAR; PG8_SCHED;
            PG8_LDB(B1, 1, 1); PG8_STAGE(PG8_SB(1, 0), b3, voffB);
            PG8_BAR; PG8_WAIT_L(0); PG8_MMA(0, 1, At, B1); PG8_BAR;
            PG8_LDA(At, 1, 1); PG8_STAGE(PG8_SA(1, 0), a3, voffA);
            PG8_BAR; PG8_WAIT_L(0); PG8_MMA(1, 0, At, B0); PG8_BAR; PG8_SCHED;
            PG8_STAGE(PG8_SB(1, 1), b3 + hstep, voffB);
            PG8_WAIT_V(6); PG8_BAR; PG8_MMA(1, 1, At, B1); PG8_BAR;
            }
        }
        if constexpr (ALIGN_EPI) { if (wr == 0) PG8_BAR; }
        if (cur.mode == 1) {
            __attribute__((address_space(1))) f32x4* pp = (__attribute__((address_space(1))) f32x4*)part + tid;
#pragma unroll
            for (int a = 0; a < 2; ++a)
#pragma unroll
                for (int b = 0; b < 2; ++b)
#pragma unroll
                    for (int m = 0; m < 4; ++m)
#pragma unroll
                        for (int n = 0; n < 2; ++n) { *pp = acc[a][b][m][n]; pp += 512; asm volatile("" : "+v"(pp)); }
        } else
        if constexpr (!Epi::AFTER_DRAIN) { E(acc, cur, wr, wc, fr, fq); S.done(cur); }
        if (!has_next) break;
        if (nxt.mode == 2) {
            const __attribute__((address_space(1))) f32x4* pp = (const __attribute__((address_space(1))) f32x4*)part + tid;
#pragma unroll
            for (int a = 0; a < 2; ++a)
#pragma unroll
                for (int b = 0; b < 2; ++b)
#pragma unroll
                    for (int m = 0; m < 4; ++m)
#pragma unroll
                        for (int n = 0; n < 2; ++n) { acc[a][b][m][n] = *pp; pp += 512; asm volatile("" : "+v"(pp)); }
        } else {
#pragma unroll
        for (int a = 0; a < 2; ++a)
#pragma unroll
            for (int b = 0; b < 2; ++b)
#pragma unroll
                for (int m = 0; m < 4; ++m)
#pragma unroll
                    for (int n = 0; n < 2; ++n) acc[a][b][m][n] = (f32x4){0.f, 0.f, 0.f, 0.f};
        }
        cur = nxt; cA = nA; cB = nB; ++ui;
        if constexpr (ALIGN_EPI) { if (wr == 1) PG8_BAR; }
    }
    PG8_WAIT_V(0);
    if constexpr (!ALIGN_EPI) { if (wr == 0) PG8_BAR; }
    PG8_BAR;
    if constexpr (Epi::AFTER_DRAIN) { E.fused(acc, cur, wr, wc, fr, fq, lds, wid, lane); S.done(cur); }
#undef PG8_SA
#undef PG8_SB
#undef PG8_STAGE
#undef PG8_LDA
#undef PG8_LDB
#undef PG8_MMA
#undef PG8_WAIT_V
#undef PG8_WAIT_L
#undef PG8_BAR
#undef PG8_SCHED
}
}

constexpr int NWAVES = 8;
constexpr int NB = 16, SEQ = 2048, D = 1024, NH = 16, HD = 64, NIN = 9216, CVK = 31;
constexpr int M = NB * SEQ;
constexpr float LN_EPS = 1e-5f;
constexpr float DN_ALPHA = 1.189207115002721f;

constexpr size_t MiB = 1u << 20;
constexpr size_t WS_CTL = 0;
constexpr size_t WS_STATS = 1 * MiB;
constexpr size_t WS_WIN = 2 * MiB;
constexpr size_t WS_WSB = 20 * MiB, WS_WCV = 22 * MiB, WS_WOUT = 24 * MiB;
constexpr size_t WS_K = 32 * MiB, WS_V = 96 * MiB, WS_SZSB = 160 * MiB, WS_U = 224 * MiB, WS_SZCV = 288 * MiB, WS_SGSB = 352 * MiB, WS_SGCV = 416 * MiB, WS_PART = 480 * MiB, WS_END = 512 * MiB;
constexpr size_t WS_MERGED = WS_K;
constexpr size_t WS_P = WS_V;

constexpr int LDS_BYTES = 147456;
constexpr int BAR_LDS_OFF = 139264;
constexpr int CW_BAR = 4096;
constexpr size_t CTL_ZERO_BYTES = 65536;

#define GAS __attribute__((address_space(1)))
#define LAS __attribute__((address_space(3)))
typedef unsigned short bf16;
typedef unsigned v4u __attribute__((ext_vector_type(4)));
typedef float f32x4 __attribute__((ext_vector_type(4)));
#define LDS_WAIT() asm volatile("s_waitcnt lgkmcnt(0)" ::: "memory")
__device__ __forceinline__ unsigned pk2(float lo, float hi) { return pg8::cvt_pk_bf16(lo, hi); }
__device__ __forceinline__ unsigned f2bf(float f) { return pk2(f, 0.f) & 0xffffu; }
__device__ __forceinline__ float bf2f(unsigned b) { return pg8::bflo(b); }

struct Frame {
    LAS unsigned char* lds;
    int tid, lane, wave, G, bid;
    const float *x, *ln_in_g, *ln_in_b, *w_in, *w_sb, *conv_w, *conv_b, *cln_g, *cln_b, *w_cv, *w_out, *lnp_g, *lnp_b;
    float* out; float* stats;
    bf16 *WIN, *WSB, *WCV, *WOUT, *XN, *ASB, *Q, *K, *V, *SZSB, *U, *SZCV, *SGSB, *SGCV, *MERGED, *P;
};

__device__ __forceinline__ float wave_sum(float v) {
#pragma unroll
    for (int o = 1; o < 64; o <<= 1) v += __shfl_xor(v, o);
    return v;
}
#define XB_TMO      128
#define XB_XCNT(j)  (256  + 64 * (j))
#define XB_XSUB(j)  (1280 + 64 * (j))
#define XB_XGEN(j)  (2304 + 64 * (j))
#define XB_TOP      3328
#define XB_TOPGEN   3392
#define XCD_BAR_WORDS 3456
#define XB_SPIN_CAP (1u << 18)

__device__ __forceinline__ unsigned xb_ld(unsigned* p)              { return __hip_atomic_load(p, __ATOMIC_RELAXED, __HIP_MEMORY_SCOPE_AGENT); }
__device__ __forceinline__ unsigned xb_add(unsigned* p, unsigned v) { return __hip_atomic_fetch_add(p, v, __ATOMIC_RELAXED, __HIP_MEMORY_SCOPE_AGENT); }
__device__ __forceinline__ unsigned xb_xcc_id() { return (unsigned)__builtin_amdgcn_s_getreg((3 << 11) | 20) & 0xFu; }
#define XB_SPIN(cond, bar) do { unsigned _sp = 0; while (cond) { __builtin_amdgcn_s_sleep(1); \
    if ((++_sp & 255u) == 0u) { if (xb_ld(&(bar)[XB_TMO])) break; if (_sp > XB_SPIN_CAP) { atomicAdd(&(bar)[XB_TMO], 1u); break; } } } } while (0)

struct XcdBarrier {
    unsigned* bar; unsigned x;
    volatile LAS unsigned* st;
};

__device__ __forceinline__ XcdBarrier xcd_barrier_post(unsigned* bar, volatile LAS unsigned* st) {
    XcdBarrier b; b.bar = bar; b.x = xb_xcc_id(); b.st = st;
    if (threadIdx.x == 0) (void)xb_add(&bar[XB_XCNT(b.x)], 1u);
    return b;
}
__device__ __forceinline__ void xcd_barrier_complete(unsigned* bar, unsigned x, unsigned& nloc, unsigned& nx) {
    const unsigned G = gridDim.x * gridDim.y * gridDim.z;
    unsigned sum, cnt, mine, sp = 0u;
    for (;;) {
        sum = 0u; cnt = 0u; mine = 0u;
#pragma unroll
        for (unsigned j = 0; j < 16; ++j) { const unsigned c = xb_ld(&bar[XB_XCNT(j)]); sum += c; cnt += (c > 0u) ? 1u : 0u; mine = (j == x) ? c : mine; }
        if (sum == G) break;
        __builtin_amdgcn_s_sleep(1);
        if ((++sp & 255u) == 0u) { if (xb_ld(&bar[XB_TMO])) break; if (sp > XB_SPIN_CAP) { atomicAdd(&bar[XB_TMO], 1u); break; } }
    }
    nloc = mine > 0u ? mine : 1u; nx = cnt > 0u ? cnt : 1u;
}

__device__ __forceinline__ void xcd_barrier(const XcdBarrier& b) {
    asm volatile("s_waitcnt vmcnt(0)" ::: "memory");
    __syncthreads();
    if (threadIdx.x == 0) {
        unsigned* bar = b.bar;
        __builtin_amdgcn_s_waitcnt(0);
        unsigned nloc = b.st[0], nx = b.st[1];
        if (nloc == 0u) { xcd_barrier_complete(bar, b.x, nloc, nx); b.st[0] = nloc; b.st[1] = nx; }
        const unsigned old = xb_add(&bar[XB_XSUB(b.x)], 1u);
        const unsigned gen = old / nloc;
        if (old + 1u == (gen + 1u) * nloc) {
            __builtin_amdgcn_fence(__ATOMIC_RELEASE, "agent");
            asm volatile("s_waitcnt vmcnt(0)" ::: "memory");
            const unsigned og = xb_add(&bar[XB_TOP], 1u);
            const unsigned tg = og / nx;
            if (og + 1u == (tg + 1u) * nx) xb_add(&bar[XB_TOPGEN], 1u);
            else XB_SPIN(xb_ld(&bar[XB_TOPGEN]) == tg, bar);
            __builtin_amdgcn_fence(__ATOMIC_ACQUIRE, "agent");
            xb_add(&bar[XB_XGEN(b.x)], 1u);
            asm volatile("s_waitcnt vmcnt(0)" ::: "memory");
        } else {
            XB_SPIN(xb_ld(&bar[XB_XGEN(b.x)]) == gen, bar);
            __builtin_amdgcn_fence(__ATOMIC_ACQUIRE, "agent");
            asm volatile("s_waitcnt vmcnt(0)" ::: "memory");
        }
    }
    __syncthreads();
}

__device__ __forceinline__ void p0_transpose_item(const float* W, int K, int N, bf16* WT, int dst_row0, int src_col0, int kb, LAS float* scr, int lane) {
    const int k0 = 64 * kb;
#pragma unroll 8
    for (int i = 0; i < 32; ++i) { const int kk = 2 * i + (lane >> 5); scr[kk * 33 + (lane & 31)] = W[(size_t)(k0 + kk) * N + src_col0 + (lane & 31)]; }
    LDS_WAIT(); asm volatile("" ::: "memory");
    const int c = lane & 7;
#pragma unroll
    for (int j = 0; j < 4; ++j) { const int n = (lane >> 3) + 8 * j; const LAS float* s = scr + (8 * c) * 33 + n;
        v4u o; o.x = pk2(s[0 * 33], s[1 * 33]); o.y = pk2(s[2 * 33], s[3 * 33]); o.z = pk2(s[4 * 33], s[5 * 33]); o.w = pk2(s[6 * 33], s[7 * 33]);
        *(GAS v4u*)(WT + (size_t)(dst_row0 + n) * K + k0 + 8 * c) = o; }
    LDS_WAIT(); asm volatile("" ::: "memory");
}
__device__ __forceinline__ int win_src_col(int n) {
    if (n < 4096 || n >= 6144) return n;
    const int r = n - 4096, j = r >> 8, q = r & 255;
    return q < 128 ? 4096 + 128 * j + q : 5120 + 128 * j + (q - 128);
}
__device__ __forceinline__ void p0_prologue(Frame& F) {
    LAS float* scr = (LAS float*)(F.lds + F.wave * 16384);
    const int gw = F.bid * NWAVES + F.wave, NGW = F.G * NWAVES;
    constexpr int I_IN = (D / 64) * (NIN / 32), I_SQ = (D / 64) * (D / 32);
    for (int it = gw; it < I_IN + 3 * I_SQ; it += NGW) {
        int r = it;
        if (r < I_IN) { const int kb = r / (NIN / 32), nb = r % (NIN / 32); p0_transpose_item(F.w_in, D, NIN, F.WIN, 32 * nb, win_src_col(32 * nb), kb, scr, F.lane); continue; } r -= I_IN;
        if (r < I_SQ) { p0_transpose_item(F.w_sb, D, D, F.WSB, 32 * (r % (D / 32)), 32 * (r % (D / 32)), r / (D / 32), scr, F.lane); continue; } r -= I_SQ;
        if (r < I_SQ) { p0_transpose_item(F.w_cv, D, D, F.WCV, 32 * (r % (D / 32)), 32 * (r % (D / 32)), r / (D / 32), scr, F.lane); continue; } r -= I_SQ;
        p0_transpose_item(F.w_out, D, D, F.WOUT, 32 * (r % (D / 32)), 32 * (r % (D / 32)), r / (D / 32), scr, F.lane);
    }
    for (int m = gw; m < M; m += NGW) {
        const GAS f32x4* xr = (const GAS f32x4*)(F.x + (size_t)m * D) + F.lane;
        f32x4 v[4]; float s = 0.f;
#pragma unroll
        for (int j = 0; j < 4; ++j) { v[j] = xr[64 * j]; s += (v[j].x + v[j].y) + (v[j].z + v[j].w); }
        const float mean = wave_sum(s) * (1.f / D); float s2 = 0.f;
#pragma unroll
        for (int j = 0; j < 4; ++j) { const f32x4 d = v[j] - mean; s2 += (d.x * d.x + d.y * d.y) + (d.z * d.z + d.w * d.w); }
        const float rstd = 1.f / sqrtf(wave_sum(s2) * (1.f / D) + LN_EPS);
        if (F.lane == 0) { F.stats[2 * m] = mean; F.stats[2 * m + 1] = rstd; }
        GAS unsigned long long* o8 = (GAS unsigned long long*)(F.XN + (size_t)m * D) + F.lane;
#pragma unroll
        for (int j = 0; j < 4; ++j) { const f32x4 g = *((const GAS f32x4*)F.ln_in_g + F.lane + 64 * j), b = *((const GAS f32x4*)F.ln_in_b + F.lane + 64 * j);
            const f32x4 y = ((v[j] - mean) * rstd) * g + b;
            o8[64 * j] = (unsigned long long)pk2(y.x, y.y) | ((unsigned long long)pk2(y.z, y.w) << 32); }
    }
}

__device__ __forceinline__ void attn_ref_task(Frame& F, int row, int h) {
    const int lane = F.lane; const int t = row & (SEQ - 1); const int rowb = row - t;
    float qd[64];
    { const GAS v4u* qp = (const GAS v4u*)(F.Q + (size_t)row * D + h * HD);
#pragma unroll
      for (int i = 0; i < 8; ++i) { const v4u w = qp[i]; qd[8 * i + 0] = bf2f(w.x & 0xffffu); qd[8 * i + 1] = bf2f(w.x >> 16); qd[8 * i + 2] = bf2f(w.y & 0xffffu); qd[8 * i + 3] = bf2f(w.y >> 16);
          qd[8 * i + 4] = bf2f(w.z & 0xffffu); qd[8 * i + 5] = bf2f(w.z >> 16); qd[8 * i + 6] = bf2f(w.w & 0xffffu); qd[8 * i + 7] = bf2f(w.w >> 16); } }
    float o = 0.f, carry = 0.f;
    for (int j = (t - 1) >> 6; j >= 0; --j) {
        const int s = 64 * j + lane;
        const GAS v4u* kp = (const GAS v4u*)(F.K + (size_t)(rowb + s) * D + h * HD);
        float xs = 0.f;
#pragma unroll
        for (int i = 0; i < 8; ++i) { const v4u w = kp[i];
            xs += qd[8 * i + 0] * bf2f(w.x & 0xffffu); xs += qd[8 * i + 1] * bf2f(w.x >> 16); xs += qd[8 * i + 2] * bf2f(w.y & 0xffffu); xs += qd[8 * i + 3] * bf2f(w.y >> 16);
            xs += qd[8 * i + 4] * bf2f(w.z & 0xffffu); xs += qd[8 * i + 5] * bf2f(w.z >> 16); xs += qd[8 * i + 6] * bf2f(w.w & 0xffffu); xs += qd[8 * i + 7] * bf2f(w.w >> 16); }
        const bool valid = s < t;
        const float sp = valid ? (fmaxf(xs, 0.f) + __builtin_amdgcn_logf(1.0f + __builtin_amdgcn_exp2f(-fabsf(xs)))) : 0.f;
        float suf = sp;
#pragma unroll
        for (int off = 1; off < 64; off <<= 1) { const float v = __shfl_down(suf, off); if (lane + off < 64) suf += v; }
        const float w = valid ? __builtin_amdgcn_exp2f(xs - (suf + carry)) : 0.f;
        carry += __shfl(suf, 0);
        const GAS bf16* vp = (const GAS bf16*)(F.V + (size_t)(rowb + 64 * j) * D + h * HD + lane);
        for (int i = 0; i < 64; ++i) { const float wi = __shfl(w, i); o += wi * bf2f(vp[(size_t)i * D]); }
    }
    const size_t oo = (size_t)row * D + h * HD + lane;
    const float sz = bf2f(F.SZSB[oo]);
    F.ASB[oo] = (bf16)f2bf(o * sz);
}
__device__ __forceinline__ void attn_ref_phase(Frame& F) {
    const int gw = F.bid * NWAVES + F.wave, NGW = F.G * NWAVES;
    for (int it = gw; it < M * NH; it += NGW) attn_ref_task(F, it >> 4, it & 15);
}

namespace sba {
using f32x16 = __attribute__((ext_vector_type(16))) float;
using bf16x8 = __attribute__((ext_vector_type(8))) short;
using s16x4 = __attribute__((ext_vector_type(4))) short;
typedef short v4i16_t __attribute__((ext_vector_type(4)));
constexpr int VDH = 4160;
constexpr int WBYTES = 8448;
constexpr float ATT_EXIT = 1.0e-9f;

__device__ __forceinline__ unsigned cvtpk(float lo, float hi) { return pg8::cvt_pk_bf16(lo, hi); }
#if USE_F16
__device__ __forceinline__ f32x16 mfma32(bf16x8 a, bf16x8 b, f32x16 c) { return __builtin_amdgcn_mfma_f32_32x32x16_f16(__builtin_bit_cast(pg8::h16x8, a), __builtin_bit_cast(pg8::h16x8, b), c, 0, 0, 0); }
#else
__device__ __forceinline__ f32x16 mfma32(bf16x8 a, bf16x8 b, f32x16 c) { return __builtin_amdgcn_mfma_f32_32x32x16_bf16(a, b, c, 0, 0, 0); }
#endif
__device__ __forceinline__ s16x4 vtr(LAS unsigned char* p) { return __builtin_bit_cast(s16x4, __builtin_amdgcn_ds_read_tr16_b64_v4i16((LAS v4i16_t*)p)); }

template <bool MASK>
__device__ __forceinline__ void tile_weights(const f32x16& p0, const f32x16& p1, float (&w)[32], float& carry, int kv0, int start, int r32, int hi) {
    float e[32], c[32], G[8];
    const int hiLim = r32 - kv0 - 4 * hi, loLim = -start - 4 * hi;
#pragma unroll
    for (int idx = 0; idx < 32; ++idx) { const int kvc = (idx >= 16 ? 32 : 0) + (idx & 3) + 8 * ((idx & 15) >> 2);
        float xv = fminf(idx < 16 ? p0[idx] : p1[idx - 16], 64.f);
        if (MASK) xv = (kvc < hiLim && kvc >= loLim) ? xv : -1000.f;
        e[idx] = __builtin_amdgcn_exp2f(xv); }
#pragma unroll
    for (int g = 0; g < 8; ++g) {
        float s = 1.f;
#pragma unroll
        for (int k = 3; k >= 0; --k) { const int idx = 4 * g + k; const float r = __builtin_amdgcn_rcpf(1.0f + e[idx]); s = (k == 3) ? r : s * r; c[idx] = s; }
        G[g] = s;
    }
    float run = carry;
#pragma unroll
    for (int g = 7; g >= 0; --g) {
        const auto rr = __builtin_amdgcn_permlane32_swap(__float_as_uint(G[g]), __float_as_uint(G[g]), false, false);
        const float ev = __uint_as_float(rr[0]), od = __uint_as_float(rr[1]);
        const float tmp = run * od; const float off = hi ? run : tmp; run = tmp * ev;
#pragma unroll
        for (int k = 0; k < 4; ++k) { const int idx = 4 * g + k; w[idx] = e[idx] * (off * c[idx]); }
    }
    carry = run;
}

__device__ __forceinline__ void attn_task(Frame& F, int b, int h, int qblk, LAS unsigned char* vl) {
    const int lane = F.lane, r32 = lane & 31, hi = lane >> 5;
    const int tw = 32 * qblk; const size_t rowb = (size_t)b * SEQ;
    const bf16* Qw = F.Q + (rowb + tw) * D + h * HD;
    const bf16* Kh = F.K + rowb * D + h * HD + hi * 8; const bf16* Vh = F.V + rowb * D + h * HD + (lane & 7) * 8;
    bf16x8 qr[4];
#pragma unroll
    for (int d0 = 0; d0 < 4; ++d0) qr[d0] = *(const GAS bf16x8*)(Qw + (size_t)r32 * D + d0 * 16 + hi * 8);
    f32x16 o[2]; o[0] = f32x16{}; o[1] = f32x16{};
    float carry = 1.f;
    LAS unsigned char* vwr = vl + ((lane & 7) >> 2) * VDH + (lane >> 3) * 64 + (lane & 3) * 16;
    LAS unsigned char* vrd = vl + ((lane >> 4) & 1) * 32 + (lane & 3) * 8 + (4 * hi + ((lane & 15) >> 2)) * 64;
    bf16x8 kf[2][4]; v4u vr[8];
#define SBA_LOAD(st) do { \
        _Pragma("unroll") for (int hh = 0; hh < 2; ++hh) { int kr = (st) + 32 * hh + r32; kr = kr < 0 ? 0 : kr; \
            _Pragma("unroll") for (int d0 = 0; d0 < 4; ++d0) kf[hh][d0] = *(const GAS bf16x8*)(Kh + (size_t)kr * D + d0 * 16); } \
        _Pragma("unroll") for (int it = 0; it < 8; ++it) { int vrw = (st) + 8 * it + (lane >> 3); vrw = vrw < 0 ? 0 : vrw; vr[it] = *(const GAS v4u*)(Vh + (size_t)vrw * D); } } while (0)
    SBA_LOAD(tw - 32);
    for (int i = 0;; ++i) {
        const int start = tw - 32 - 64 * i;
        f32x16 p0 = f32x16{}, p1 = f32x16{};
#pragma unroll
        for (int d0 = 0; d0 < 4; ++d0) { p0 = mfma32(kf[0][d0], qr[d0], p0); p1 = mfma32(kf[1][d0], qr[d0], p1); }
#pragma unroll
        for (int it = 0; it < 8; ++it) *(LAS v4u*)(vwr + it * 512) = vr[it];
        SBA_LOAD(start - 64);
        float w[32];
        if (i == 0 || start < 0) tile_weights<true>(p0, p1, w, carry, start - tw, start, r32, hi);
        else tile_weights<false>(p0, p1, w, carry, start - tw, start, r32, hi);
        bf16x8 pa[4];
#pragma unroll
        for (int ks = 0; ks < 4; ++ks) { v4u t; t.x = cvtpk(w[8 * ks + 0], w[8 * ks + 1]); t.y = cvtpk(w[8 * ks + 2], w[8 * ks + 3]); t.z = cvtpk(w[8 * ks + 4], w[8 * ks + 5]); t.w = cvtpk(w[8 * ks + 6], w[8 * ks + 7]); pa[ks] = __builtin_bit_cast(bf16x8, t); }
#pragma unroll
        for (int d0 = 0; d0 < 2; ++d0)
#pragma unroll
            for (int ks = 0; ks < 4; ++ks) { const s16x4 lo = vtr(vrd + d0 * VDH + ks * 1024), hi4 = vtr(vrd + d0 * VDH + ks * 1024 + 512);
                const bf16x8 vf = (bf16x8){lo[0], lo[1], lo[2], lo[3], hi4[0], hi4[1], hi4[2], hi4[3]};
                o[d0] = mfma32(pa[ks], vf, o[d0]); }
        if (start - 64 <= -64 || __all(carry < ATT_EXIT)) break;
    }
#undef SBA_LOAD
    LAS float* stg = (LAS float*)vl;
#pragma unroll
    for (int r = 0; r < 16; ++r) { const int q = (r & 3) + 8 * (r >> 2) + 4 * hi;
#pragma unroll
        for (int d0 = 0; d0 < 2; ++d0) stg[q * 64 + d0 * 32 + r32] = o[d0][r]; }
    const bf16* Zw = F.SZSB + (rowb + tw) * D + h * HD; bf16* Ow = F.ASB + (rowb + tw) * D + h * HD;
#pragma unroll
    for (int it = 0; it < 4; ++it) { const int row = it * 8 + (lane >> 3), ch = lane & 7;
        const f32x4 a0 = *(const LAS f32x4*)(stg + row * 64 + ch * 8), a1 = *(const LAS f32x4*)(stg + row * 64 + ch * 8 + 4);
        pg8::f32x4 z0, z1; pg8::unpack8(*(const GAS pg8::u32x4*)(Zw + (size_t)row * D + ch * 8), z0, z1);
        *(GAS pg8::u32x4*)(Ow + (size_t)row * D + ch * 8) = pg8::pack8(a0 * z0, a1 * z1); }
}
__device__ __forceinline__ void attn_phase(Frame& F) {
    LAS unsigned char* vl = F.lds + F.wave * WBYTES;
    for (int it = 0;; ++it) {
        const int tsk = (it * F.G + F.bid) * NWAVES + F.wave;
        if (tsk >= NB * NH * (SEQ / 32)) break;
        const int bh = tsk >> 6, qblk = tsk & 63;
        attn_task(F, bh >> 4, bh & 15, qblk, vl);
    }
}
}

typedef float f32x2 __attribute__((ext_vector_type(2)));
__device__ __forceinline__ float dppf(float v, const int ctrl_unused) { return v; }
#define DPP_ADD(v, ctrl) ((v) + __builtin_bit_cast(float, __builtin_amdgcn_update_dpp(0, __builtin_bit_cast(int, (v)), (ctrl), 0xF, 0xF, true)))
__device__ __forceinline__ float row_allsum(float v) {
    v = DPP_ADD(v, 0xB1); v = DPP_ADD(v, 0x4E); v = DPP_ADD(v, 0x124); v = DPP_ADD(v, 0x128); return v;
}
__device__ __forceinline__ void conv_phase(Frame& F, const int dry = 0) {
    const int tid = F.tid, c = 2 * tid, lane = F.lane;
    f32x2 wv[CVK];
#pragma unroll
    for (int k = 0; k < CVK; ++k) wv[k] = *(const GAS f32x2*)(F.conv_w + k * D + c);
    const f32x2 cb = *(const GAS f32x2*)(F.conv_b + c), lg = *(const GAS f32x2*)(F.cln_g + c), lb = *(const GAS f32x2*)(F.cln_b + c);
    LAS float* red = (LAS float*)(F.lds + 69632);
    const int li = lane & 15, R = lane >> 4;
    for (int tile = F.bid; tile < M / 128; tile += F.G) {
        const int t0 = tile * 128;
        const GAS unsigned* Up = (const GAS unsigned*)(F.U + (size_t)t0 * D + c);
        GAS unsigned* Zp = (GAS unsigned*)(F.SZCV + (size_t)t0 * D + c);
        f32x2 ring[32];
        const bool has_hist = (t0 & (SEQ - 1)) != 0;
#pragma unroll
        for (int r = 2; r < 32; ++r) { unsigned w = 0u; if (has_hist) w = Up[(r - 32) * (D / 2)]; ring[r] = (f32x2){bf2f(w & 0xffffu), bf2f(w >> 16)}; }
        ring[0] = (f32x2){0.f, 0.f}; ring[1] = (f32x2){0.f, 0.f};
        unsigned pre[8], zpre[8];
#pragma unroll
        for (int e = 0; e < 8; ++e) { pre[e] = Up[e * (D / 2)]; zpre[e] = Zp[e * (D / 2)]; }
        for (int blk = 0; blk < 4; ++blk) {
#pragma unroll
            for (int g = 0; g < 4; ++g) {
                const int rb = 32 * blk + 8 * g;
                unsigned cur[8], zc[8];
#pragma unroll
                for (int e = 0; e < 8; ++e) { cur[e] = pre[e]; zc[e] = zpre[e]; }
#pragma unroll
                for (int e = 0; e < 8; ++e) { pre[e] = Up[(rb + 8 + e) * (D / 2)]; zpre[e] = Zp[(rb + 8 + e) * (D / 2)]; }
                f32x2 y[8]; float st[16];
#pragma unroll
                for (int e = 0; e < 8; ++e) { const int j = 8 * g + e;
                    ring[j] = (f32x2){bf2f(cur[e] & 0xffffu), bf2f(cur[e] >> 16)};
                    f32x2 a = cb;
#pragma unroll
                    for (int k = 0; k < CVK; ++k) a += wv[k] * ring[(j + 2 + k) & 31];
                    y[e] = a; st[2 * e] = a.x + a.y; st[2 * e + 1] = a.x * a.x + a.y * a.y; }
                float a8[8], b4[4];
#pragma unroll
                for (int i = 0; i < 8; ++i) { const auto rr = __builtin_amdgcn_permlane32_swap(__float_as_uint(st[i]), __float_as_uint(st[i + 8]), false, false); a8[i] = __uint_as_float(rr[0]) + __uint_as_float(rr[1]); }
#pragma unroll
                for (int i = 0; i < 4; ++i) { const auto rr = __builtin_amdgcn_permlane16_swap(__float_as_uint(a8[i]), __float_as_uint(a8[i + 4]), false, false); b4[i] = row_allsum(__uint_as_float(rr[0]) + __uint_as_float(rr[1])); }
                LAS float* rp = red + (g & 1) * 128;
                { const float val = li == 0 ? b4[0] : li == 1 ? b4[1] : li == 2 ? b4[2] : b4[3]; if (li < 4) rp[(4 * R + li) * 8 + F.wave] = val; }
                __syncthreads();
                float tot = 0.f;
                if (lane < 16) { const f32x4 p = *(const LAS f32x4*)(rp + lane * 8), q = *(const LAS f32x4*)(rp + lane * 8 + 4); tot = ((p.x + p.y) + (p.z + p.w)) + ((q.x + q.y) + (q.z + q.w)); }
#pragma unroll
                for (int e = 0; e < 8; ++e) {
                    const float s1 = __builtin_amdgcn_readlane(tot, 2 * e), s2 = __builtin_amdgcn_readlane(tot, 2 * e + 1);
                    const float mean = s1 * (1.f / D), var = fmaxf(s2 * (1.f / D) - mean * mean, 0.f);
                    const float rstd = 1.f / sqrtf(var + LN_EPS);
                    const f32x2 yn = ((y[e] - mean) * rstd) * lg + lb;
                    const unsigned res = pk2(yn.x * pg8::sigmoidf_(yn.x) * bf2f(zc[e] & 0xffffu), yn.y * pg8::sigmoidf_(yn.y) * bf2f(zc[e] >> 16));
                    if (!dry) Zp[(rb + e) * (D / 2)] = res; }
            }
        }
    }
}

__device__ __forceinline__ void lnpost_phase(Frame& F, const int dry = 0) {
    const int gw = F.bid * NWAVES + F.wave, NGW = F.G * NWAVES;
    for (int m = gw; m < M; m += NGW) {
        GAS f32x4* xr = (GAS f32x4*)(F.out + (size_t)m * D) + F.lane;
        f32x4 v[4]; float s = 0.f;
#pragma unroll
        for (int j = 0; j < 4; ++j) { v[j] = xr[64 * j]; s += (v[j].x + v[j].y) + (v[j].z + v[j].w); }
        const float mean = wave_sum(s) * (1.f / D); float s2 = 0.f;
#pragma unroll
        for (int j = 0; j < 4; ++j) { v[j] = v[j] - mean; s2 += (v[j].x * v[j].x + v[j].y * v[j].y) + (v[j].z * v[j].z + v[j].w * v[j].w); }
        const float rstd = 1.f / sqrtf(wave_sum(s2) * (1.f / D) + LN_EPS);
#pragma unroll
        for (int j = 0; j < 4; ++j) { const f32x4 g = *((const GAS f32x4*)F.lnp_g + F.lane + 64 * j), b = *((const GAS f32x4*)F.lnp_b + F.lane + 64 * j); const f32x4 res = (v[j] * rstd) * g + b; if (!dry) xr[64 * j] = res; }
    }
}

#ifndef P1_STAGGER
#define P1_STAGGER 0
#endif
#ifndef PROBE_DRY_ALL
#define PROBE_DRY_ALL 1
#endif
struct Args { const float* in[13]; float* out; unsigned char* ws; int ph_lo, ph_hi, fused, dry, li, pad; };
constexpr int NPHASE = 8;
__global__ void __launch_bounds__(NWAVES * 64, 2) fwd_kernel(Args args) {
    extern __shared__ __attribute__((aligned(16))) unsigned char lds[];
    Frame F;
    F.lds = (LAS unsigned char*)lds;
    F.tid = threadIdx.x; F.lane = F.tid & 63; F.wave = __builtin_amdgcn_readfirstlane(F.tid >> 6); F.G = gridDim.x; F.bid = blockIdx.x;
    unsigned char* ws = args.ws;
    F.x = args.in[0]; F.ln_in_g = args.in[1]; F.ln_in_b = args.in[2]; F.w_in = args.in[3]; F.w_sb = args.in[4]; F.conv_w = args.in[5]; F.conv_b = args.in[6];
    F.cln_g = args.in[7]; F.cln_b = args.in[8]; F.w_cv = args.in[9]; F.w_out = args.in[10]; F.lnp_g = args.in[11]; F.lnp_b = args.in[12];
    F.out = args.out; F.stats = (float*)(ws + WS_STATS);
    F.WIN = (bf16*)(ws + WS_WIN); F.WSB = (bf16*)(ws + WS_WSB); F.WCV = (bf16*)(ws + WS_WCV); F.WOUT = (bf16*)(ws + WS_WOUT);
    F.XN = (bf16*)args.out; F.ASB = (bf16*)args.out; F.Q = (bf16*)args.out + (size_t)M * D;
    F.K = (bf16*)(ws + WS_K); F.V = (bf16*)(ws + WS_V); F.SZSB = (bf16*)(ws + WS_SZSB); F.U = (bf16*)(ws + WS_U); F.SZCV = (bf16*)(ws + WS_SZCV);
    F.SGSB = (bf16*)(ws + WS_SGSB); F.SGCV = (bf16*)(ws + WS_SGCV); F.MERGED = (bf16*)(ws + WS_MERGED); F.P = (bf16*)(ws + WS_P);
    const int lo = args.ph_lo, hi = args.ph_hi; const bool fused = args.fused != 0;
    volatile LAS unsigned* bst = (volatile LAS unsigned*)(F.lds + BAR_LDS_OFF);
    if (F.tid < 2) bst[F.tid] = 0u;
    __syncthreads();
    XcdBarrier bar; bar.bar = (unsigned*)(ws + WS_CTL) + CW_BAR + args.li * XCD_BAR_WORDS; bar.x = 0; bar.st = nullptr;
    if (fused) bar = xcd_barrier_post((unsigned*)(ws + WS_CTL) + CW_BAR + args.li * XCD_BAR_WORDS, bst);
#define IN(k) (lo <= (k) && (k) < hi)
#if defined(USE_CG_SYNC)
#define SEAM(k) do { if (fused && IN(k) && IN((k) + 1)) { cg::this_grid().sync(); } } while (0)
#else
#define SEAM(k) do { if (fused && IN(k) && IN((k) + 1)) { xcd_barrier(bar); } } while (0)
#endif

    if (IN(0)) { p0_prologue(F); } SEAM(0);
    if (IN(1)) {
        pg8::Gemm g{F.XN, F.WIN, M, NIN, D}; pg8::StaggerOrder S; S.init2(M, NIN, F.G, F.bid, (P1_STAGGER && F.G == 256) ? (F.bid & 1) : 0);
        pg8::f32x4* part = (pg8::f32x4*)(ws + WS_PART) + (size_t)(F.bid >> 1) * (65536 / 4);
        pg8::EpiIn E{F.Q, F.K, F.V, F.SZSB, F.U, F.SZCV, F.SGSB, F.SGCV, (args.dry & 2) && (PROBE_DRY_ALL || ((F.bid >> 3) & 1))};
        pg8::gemm_phase<pg8::EpiIn, pg8::StaggerOrder, true, true>(F.lds, g, S, E, part);
    } SEAM(1);
    #if defined(ATTN_REF)
    if (IN(2)) { attn_ref_phase(F); }
    if (IN(3)) { conv_phase(F, args.dry & 8); } SEAM(3);
#else
    if (IN(2)) { sba::attn_phase(F); }
    if (IN(3)) { conv_phase(F, args.dry & 8); } SEAM(3);
#endif
    if (IN(4)) {
        pg8::Gemm g{F.ASB, F.WSB, M, D, D}; pg8::StaticOrder S; S.init(M, D, F.G, F.bid);
        pg8::EpiGate E{F.SGSB, F.P};
        pg8::gemm_phase<pg8::EpiGate, pg8::StaticOrder, true, true>(F.lds, g, S, E);
    } SEAM(4);
    if (IN(5)) {
        pg8::Gemm g{F.SZCV, F.WCV, M, D, D}; pg8::StaticOrder S; S.init(M, D, F.G, F.bid);
        pg8::EpiGateAdd E{F.SGCV, F.P, F.MERGED};
        pg8::gemm_phase<pg8::EpiGateAdd, pg8::StaticOrder, true, true>(F.lds, g, S, E);
    } SEAM(5);
    if (IN(6)) {
        pg8::Gemm g{F.MERGED, F.WOUT, M, D, D}; pg8::StaticOrder S; S.init(M, D, F.G, F.bid);
        pg8::EpiOut E{F.x, F.stats, F.ln_in_g, F.ln_in_b, F.out, DN_ALPHA};
        pg8::gemm_phase<pg8::EpiOut, pg8::StaticOrder, true, true>(F.lds, g, S, E);
    } SEAM(6);
    if (IN(7)) { lnpost_phase(F, args.dry & 128); }
#undef IN
#undef SEAM
}

#ifndef MK_N_LAUNCHES
#define MK_N_LAUNCHES 1
#endif
extern "C" void kernel_launch(void* const* d_in, const int* in_sizes, int n_in, void* d_out, int out_size, void* d_ws, size_t ws_size, hipStream_t stream) {
    static int grid = 0;
    if (grid == 0) {
        if (n_in != 13 || in_sizes[0] != M * D || out_size != M * D || ws_size < WS_END) { fprintf(stderr, "kernel_launch: unexpected shapes (n_in %d, in0 %d, out %d, ws %zu); nothing launched\n", n_in, n_in > 0 ? in_sizes[0] : -1, out_size, ws_size); grid = -1; return; }
        int dev = 0, cus = 0, per_cu = 0;
        if (hipGetDevice(&dev) != hipSuccess || hipDeviceGetAttribute(&cus, hipDeviceAttributeMultiprocessorCount, dev) != hipSuccess) { grid = -1; return; }
        if (hipFuncSetAttribute((const void*)fwd_kernel, hipFuncAttributeMaxDynamicSharedMemorySize, LDS_BYTES) != hipSuccess) { fprintf(stderr, "kernel_launch: hipFuncSetAttribute failed\n"); grid = -1; return; }
        if (hipOccupancyMaxActiveBlocksPerMultiprocessor(&per_cu, (const void*)fwd_kernel, NWAVES * 64, LDS_BYTES) != hipSuccess || per_cu < 1) { fprintf(stderr, "kernel_launch: occupancy query says %d blocks per CU\n", per_cu); (void)hipGetLastError(); grid = -1; return; }
        grid = cus * (per_cu < 1 ? 1 : 1);
    }
    if (grid < 0) return;
    if (hipMemsetAsync((char*)d_ws + WS_CTL, 0, CTL_ZERO_BYTES, stream) != hipSuccess) { fprintf(stderr, "kernel_launch: hipMemsetAsync failed\n"); return; }
    Args a{};
    for (int i = 0; i < 13; ++i) a.in[i] = (const float*)d_in[i];
    a.out = (float*)d_out; a.ws = (unsigned char*)d_ws;
#if defined(PROBE_SPLIT)
    for (int li = 0; li < 2; ++li) {
        a.ph_lo = li == 0 ? 0 : PROBE_SPLIT; a.ph_hi = li == 0 ? PROBE_SPLIT + 1 : NPHASE; a.fused = 1; a.li = li;
#if defined(PROBE_DRY)
        a.dry = li == 0 ? (1 << PROBE_SPLIT) : 0;
#endif
        void* kargs[] = {&a};
        hipError_t e = hipLaunchCooperativeKernel((const void*)fwd_kernel, dim3(grid), dim3(NWAVES * 64), kargs, LDS_BYTES, stream);
        if (e != hipSuccess) fprintf(stderr, "kernel_launch: cooperative launch failed: %s (grid %d)\n", hipGetErrorString(e), grid);
    }
#else
    if (MK_N_LAUNCHES == 1) {
        a.ph_lo = 0; a.ph_hi = NPHASE; a.fused = 1;
        void* kargs[] = {&a};
        hipError_t e = hipLaunchCooperativeKernel((const void*)fwd_kernel, dim3(grid), dim3(NWAVES * 64), kargs, LDS_BYTES, stream);
        if (e != hipSuccess) fprintf(stderr, "kernel_launch: cooperative launch failed: %s (grid %d)\n", hipGetErrorString(e), grid);
    } else {
        for (int ph = 0; ph < NPHASE; ++ph) {
            a.ph_lo = ph; a.ph_hi = ph + 1; a.fused = 0;
            hipLaunchKernelGGL(fwd_kernel, dim3(grid), dim3(NWAVES * 64), LDS_BYTES, stream, a);
        }
    }
#endif
}
```

```cpp
#include <hip/hip_runtime.h>
#include <hip/hip_cooperative_groups.h>
#include <cstdio>
#include <cstdint>
namespace cg = cooperative_groups;

namespace pg8 {
#define PG8_LAS __attribute__((address_space(3)))
typedef unsigned short bf16_t;
typedef short bf16x8 __attribute__((ext_vector_type(8)));
typedef float f32x4 __attribute__((ext_vector_type(4)));
typedef unsigned u32x4 __attribute__((ext_vector_type(4)));
constexpr int BM = 256, BK = 64, HALF = 128, HTB = HALF * BK * 2  , STAGE_BYTES = 8 * HTB, NXCD = 8, WGM = 8;

__host__ __device__ __forceinline__ int lds_byte(int r, int c) { const int st = (r >> 4) * 2 + (c >> 5), rr = r & 15, cc = c & 31, ob = rr * 64 + cc * 2; return st * 1024 + (ob ^ (((ob >> 9) & 1) << 5)); }
__host__ __device__ __forceinline__ void stage_rc(int b, int& R, int& C) { const int st = b / 1024, sb = b % 1024, swz = sb ^ (((sb >> 9) & 1) << 5); R = (st >> 1) * 16 + swz / 64; C = (st & 1) * 32 + (swz % 64) / 2; }
__host__ __device__ __forceinline__ int perm32(int rho) { const int n = rho >> 4, i = rho & 15; return 8 * (i >> 2) + 4 * n + (i & 3); }

struct Unit { int pm, pn, kt0, nkt, mode; };
struct Gemm { const bf16_t* A; const bf16_t* Bt; int M, N, K; };

struct StaticOrder {
    int nM, nN, nwg, G, c, nkt;
    __host__ __device__ void init(int M, int N, int G_, int c_, int K = 1024) { nM = M / BM; nN = N / BM; nwg = nM * nN; G = G_; c = c_; nkt = K / BK; }
    __host__ __device__ bool next(int i, Unit& u) const {
        const long L = (long)i * G + c; if (L >= nwg) return false;
        int wgid = (int)L; { const int q = nwg / NXCD, r = nwg % NXCD, xcd = wgid % NXCD, off = wgid / NXCD; wgid = (xcd < r ? xcd * (q + 1) : r * (q + 1) + (xcd - r) * q) + off; }
        const int nig = WGM * nN, gid = wgid / nig, fm = gid * WGM, gsz = (nM - fm) < WGM ? (nM - fm) : WGM;
        u.pm = fm + ((wgid % nig) % gsz); u.pn = (wgid % nig) / gsz; u.kt0 = 0; u.nkt = nkt; u.mode = 0; return true;
    }
    __device__ __forceinline__ void a_ready(const Unit&) const {}
    __device__ __forceinline__ void done(const Unit&) const {}
};

struct StaggerOrder : StaticOrder {
    int stag, n;
    __host__ __device__ void init2(int M, int N, int G_, int c_, int stag_, int K = 1024) { init(M, N, G_, c_, K); stag = stag_; n = (nwg - c + G - 1) / G; if (n < 2 || (nkt & 3)) stag = 0; }
    __host__ __device__ bool next(int i, Unit& u) const {
        if (!stag) return StaticOrder::next(i, u);
        if (i > n) return false;
        if (i == 0) { StaticOrder::next(0, u); u.nkt = nkt / 2; u.mode = 1; return true; }
        if (i == n) { StaticOrder::next(0, u); u.kt0 = nkt / 2; u.nkt = nkt / 2; u.mode = 2; return true; }
        return StaticOrder::next(i, u);
    }
};

#ifndef USE_F16
#define USE_F16 0
#endif
typedef _Float16 h16x2 __attribute__((ext_vector_type(2)));
typedef _Float16 h16x8 __attribute__((ext_vector_type(8)));
typedef float f32x2p __attribute__((ext_vector_type(2)));
#if USE_F16
__device__ __forceinline__ unsigned cvt_pk_bf16(float lo, float hi) { const f32x2p v = {lo, hi}; return __builtin_bit_cast(unsigned, __builtin_convertvector(v, h16x2)); }
__device__ __forceinline__ float bflo(unsigned w) { return (float)__builtin_bit_cast(h16x2, w)[0]; }
__device__ __forceinline__ float bfhi(unsigned w) { return (float)__builtin_bit_cast(h16x2, w)[1]; }
__device__ __forceinline__ f32x4 mfma16(bf16x8 a, bf16x8 b, f32x4 c) { return __builtin_amdgcn_mfma_f32_16x16x32_f16(__builtin_bit_cast(h16x8, a), __builtin_bit_cast(h16x8, b), c, 0, 0, 0); }
#else
__device__ __forceinline__ unsigned cvt_pk_bf16(float lo, float hi) { unsigned r; asm volatile("v_cvt_pk_bf16_f32 %0, %1, %2" : "=v"(r) : "v"(lo), "v"(hi)); return r; }
__device__ __forceinline__ float bflo(unsigned w) { return __uint_as_float(w << 16); }
__device__ __forceinline__ float bfhi(unsigned w) { return __uint_as_float(w & 0xffff0000u); }
__device__ __forceinline__ f32x4 mfma16(bf16x8 a, bf16x8 b, f32x4 c) { return __builtin_amdgcn_mfma_f32_16x16x32_bf16(a, b, c, 0, 0, 0); }
#endif
__device__ __forceinline__ float sigmoidf_(float x) { return __builtin_amdgcn_rcpf(1.0f + __builtin_amdgcn_exp2f(-1.4426950408889634f * x)); }
__device__ __forceinline__ f32x4 sig4(f32x4 v) { return (f32x4){sigmoidf_(v[0]), sigmoidf_(v[1]), sigmoidf_(v[2]), sigmoidf_(v[3])}; }
__device__ __forceinline__ u32x4 pack8(f32x4 v0, f32x4 v1) { u32x4 w; w.x = cvt_pk_bf16(v0[0], v0[1]); w.y = cvt_pk_bf16(v0[2], v0[3]); w.z = cvt_pk_bf16(v1[0], v1[1]); w.w = cvt_pk_bf16(v1[2], v1[3]); return w; }
__device__ __forceinline__ void unpack8(u32x4 w, f32x4& v0, f32x4& v1) { v0 = (f32x4){bflo(w.x), bfhi(w.x), bflo(w.y), bfhi(w.y)}; v1 = (f32x4){bflo(w.z), bfhi(w.z), bflo(w.w), bfhi(w.w)}; }

#ifndef EPI2_STORE_AUX
#define EPI2_STORE_AUX 0
#endif
#ifndef EPI3_STORE_AUX
#define EPI3_STORE_AUX 0
#endif
#ifndef EPI_STORE_AUX
#define EPI_STORE_AUX 18
#endif
template <int AUX> __device__ __forceinline__ void store16f(float* base, unsigned byte_off, f32x4 v) {
  if constexpr (AUX == 0) {
    *(f32x4*)((char*)base + byte_off) = v;
  } else {
    __builtin_amdgcn_raw_buffer_store_b128(__builtin_bit_cast(u32x4, v), __builtin_amdgcn_make_buffer_rsrc(base, 0, 0x8000000, 0x00020000), byte_off, 0, AUX);
  }
}
template <int AUX> __device__ __forceinline__ void store16(bf16_t* base, unsigned byte_off, u32x4 v) {
  if constexpr (AUX == 0) {
    *(u32x4*)((char*)base + byte_off) = v;
  } else {
    __builtin_amdgcn_raw_buffer_store_b128(v, __builtin_amdgcn_make_buffer_rsrc(base, 0, 0x4000000, 0x00020000), byte_off, 0, AUX);
  }
}
constexpr float QSCALE = 0.125f * 1.4426950408889634f;

struct EpiIn {
    static constexpr bool PERM = true, AFTER_DRAIN = false;
    bf16_t *Q, *Kb, *Vb, *SZSB, *U, *SZCV, *SGSB, *SGCV; int dry;
    __device__ __forceinline__ void operator()(const f32x4 (&acc)[2][2][4][2], const Unit& u, int wr, int wc, int fr, int fq) const {
        const int row0 = u.pm * BM + wr * 64 + fr; const int pn = u.pn;
        if (pn >= 16 && pn < 24) {
            const unsigned col = (pn - 16) * 128 + wc * 32 + 8 * fq;
#pragma unroll
            for (int ai = 0; ai < 2; ++ai)
#pragma unroll
                for (int m = 0; m < 4; ++m) { const unsigned off = ((unsigned)(row0 + ai * HALF + m * 16) * 1024u + col) * 2u;
                    const f32x4 v0 = acc[ai][0][m][0] * sig4(acc[ai][1][m][0]), v1 = acc[ai][0][m][1] * sig4(acc[ai][1][m][1]);
                    const u32x4 pk = pack8(v0, v1); if (!dry) store16<EPI_STORE_AUX>(U, off, pk); }
            return;
        }
        const int grp = pn >> 2; int mode; bf16_t* base;
        float sc = 1.f;
        if (grp == 0) { base = Q; mode = 0; sc = QSCALE; } else if (grp == 1) { base = Kb; mode = 0; } else if (grp == 2) { base = Vb; mode = 0; }
        else if (grp == 3) { base = SZSB; mode = 1; } else if (grp == 6) { base = SZCV; mode = 1; } else if (grp == 7) { base = SGSB; mode = 2; } else { base = SGCV; mode = 2; }
        const unsigned col = (pn & 3) * BM + wc * 32 + 8 * fq;
#pragma unroll
        for (int ai = 0; ai < 2; ++ai)
#pragma unroll
            for (int m = 0; m < 4; ++m) { const unsigned off = ((unsigned)(row0 + ai * HALF + m * 16) * 1024u + col) * 2u;
#pragma unroll
                for (int bj = 0; bj < 2; ++bj) { f32x4 v0 = acc[ai][bj][m][0], v1 = acc[ai][bj][m][1];
                    if (mode == 0) { v0 = v0 * sc; v1 = v1 * sc; }
                    else if (mode == 1) { v0 = v0 * sig4(v0); v1 = v1 * sig4(v1); }
                    else { v0 = sig4(v0); v1 = sig4(v1); }
                    const u32x4 pk = pack8(v0, v1); if (!dry) store16<EPI_STORE_AUX>(base, off + bj * HALF * 2, pk); } }
    }
};
struct EpiGate {
    static constexpr bool PERM = true, AFTER_DRAIN = false;
    const bf16_t* G; bf16_t* P;
    __device__ __forceinline__ void operator()(const f32x4 (&acc)[2][2][4][2], const Unit& u, int wr, int wc, int fr, int fq) const {
        const int row0 = u.pm * BM + wr * 64 + fr, col0 = u.pn * BM + wc * 32 + 8 * fq;
#pragma unroll
        for (int ai = 0; ai < 2; ++ai)
#pragma unroll
            for (int m = 0; m < 4; ++m) { const size_t off = (size_t)(row0 + ai * HALF + m * 16) * 1024 + col0;
#pragma unroll
                for (int bj = 0; bj < 2; ++bj) { f32x4 g0, g1; unpack8(*(const u32x4*)(G + off + bj * HALF), g0, g1);
                    store16<EPI2_STORE_AUX>(P, (unsigned)(off + bj * HALF) * 2u, pack8(acc[ai][bj][m][0] * g0, acc[ai][bj][m][1] * g1)); } }
    }
};
struct EpiGateAdd {
    static constexpr bool PERM = true, AFTER_DRAIN = false;
    const bf16_t* G; const bf16_t* P; bf16_t* O;
    __device__ __forceinline__ void operator()(const f32x4 (&acc)[2][2][4][2], const Unit& u, int wr, int wc, int fr, int fq) const {
        const int row0 = u.pm * BM + wr * 64 + fr, col0 = u.pn * BM + wc * 32 + 8 * fq;
#pragma unroll
        for (int ai = 0; ai < 2; ++ai)
#pragma unroll
            for (int m = 0; m < 4; ++m) { const size_t off = (size_t)(row0 + ai * HALF + m * 16) * 1024 + col0;
#pragma unroll
                for (int bj = 0; bj < 2; ++bj) { f32x4 g0, g1, p0, p1; unpack8(*(const u32x4*)(G + off + bj * HALF), g0, g1); unpack8(*(const u32x4*)(P + off + bj * HALF), p0, p1);
                    store16<EPI2_STORE_AUX>(O, (unsigned)(off + bj * HALF) * 2u, pack8(p0 + acc[ai][bj][m][0] * g0, p1 + acc[ai][bj][m][1] * g1)); } }
    }
};
struct EpiOut {
    static constexpr bool PERM = false, AFTER_DRAIN = false;
    const float* x; const float* stats; const float* g; const float* b; float* C; float alpha;
    __device__ __forceinline__ void operator()(const f32x4 (&acc)[2][2][4][2], const Unit& u, int wr, int wc, int fr, int fq) const {
        const int row0 = u.pm * BM + wr * 64 + fr, col0 = u.pn * BM + wc * 32 + 4 * fq;
        f32x4 gv[2][2], bv[2][2];
#pragma unroll
        for (int bj = 0; bj < 2; ++bj)
#pragma unroll
            for (int n = 0; n < 2; ++n) { gv[bj][n] = *(const f32x4*)(g + col0 + bj * HALF + n * 16) * alpha; bv[bj][n] = *(const f32x4*)(b + col0 + bj * HALF + n * 16) * alpha; }
#pragma unroll
        for (int ai = 0; ai < 2; ++ai)
#pragma unroll
            for (int m = 0; m < 4; ++m) { const int row = row0 + ai * HALF + m * 16; const size_t off = (size_t)row * 1024 + col0;
                const float mu = stats[2 * row], rs = stats[2 * row + 1];
#pragma unroll
                for (int bj = 0; bj < 2; ++bj)
#pragma unroll
                    for (int n = 0; n < 2; ++n) { const f32x4 xv = *(const f32x4*)(x + off + bj * HALF + n * 16);
                        store16f<EPI3_STORE_AUX>(C, (unsigned)(off + bj * HALF + n * 16) * 4u, ((xv - mu) * rs) * gv[bj][n] + bv[bj][n] + acc[ai][bj][m][n]); } }
    }
};

template <class Epi, class Sched, bool ALIGN_EPI = false, bool SP2 = false>
__device__ __forceinline__ void gemm_phase(PG8_LAS unsigned char* lds, const Gemm g, const Sched& S, const Epi& E, f32x4* part = nullptr) {
    const int tid = threadIdx.x, wid = __builtin_amdgcn_readfirstlane(tid >> 6), lane = tid & 63, wr = wid >> 2, wc = wid & 3, fr = lane & 15, fq = lane >> 4;
    const int K = g.K;
    unsigned voffA[2], voffB[2];
#pragma unroll
    for (int i = 0; i < 2; ++i) { int R, C; stage_rc(tid * 16 + i * 8192, R, C); const int Rb = Epi::PERM ? ((R & ~31) + perm32(R & 31)) : R;
        voffA[i] = (unsigned)(R * K + C) * 2u; voffB[i] = (unsigned)(Rb * K + C) * 2u; }
    const size_t kstep = (size_t)(BK * 2);
    const size_t hstep = (size_t)HALF * K * 2;
    const size_t tstep = 2 * hstep;
    const unsigned ldsw = (unsigned)wid * 1024u;
    const int aoff = lds_byte(wr * 64 + fr, fq * 8), boff = lds_byte(wc * 32 + fr, fq * 8);
#define PG8_SA(b, h) (((b) * 2 + (h)) * HTB)
#define PG8_SB(b, h) ((4 + (b) * 2 + (h)) * HTB)
#define PG8_STAGE(bufoff, gbase, voff) do { _Pragma("unroll") for (int _i = 0; _i < 2; ++_i) \
        __builtin_amdgcn_global_load_lds((const unsigned*)((const char*)(gbase) + (voff)[_i]), (PG8_LAS unsigned*)(lds + (bufoff) + ldsw + _i * 8192), 16, 0, 0); } while (0)
#define PG8_LDA(dst, b, h) do { _Pragma("unroll") for (int m = 0; m < 4; ++m) _Pragma("unroll") for (int k = 0; k < 2; ++k) dst[m][k] = *(const PG8_LAS bf16x8*)(lds + PG8_SA(b, h) + aoff + m * 2048 + k * 1024); } while (0)
#define PG8_LDB(dst, b, h) do { _Pragma("unroll") for (int n = 0; n < 2; ++n) _Pragma("unroll") for (int k = 0; k < 2; ++k) dst[n][k] = *(const PG8_LAS bf16x8*)(lds + PG8_SB(b, h) + boff + n * 2048 + k * 1024); } while (0)
#define PG8_MMA(ai, bj, At, Bt) do { __builtin_amdgcn_s_setprio(1); _Pragma("unroll") for (int m = 0; m < 4; ++m) _Pragma("unroll") for (int n = 0; n < 2; ++n) _Pragma("unroll") for (int k = 0; k < 2; ++k) \
        acc[ai][bj][m][n] = mfma16(Bt[n][k], At[m][k], acc[ai][bj][m][n]); __builtin_amdgcn_s_setprio(0); } while (0)
#define PG8_WAIT_V(n) asm volatile("s_waitcnt vmcnt(" #n ")" ::: "memory")
#define PG8_WAIT_L(n) asm volatile("s_waitcnt lgkmcnt(" #n ")" ::: "memory")
#define PG8_BAR __builtin_amdgcn_s_barrier()
#define PG8_SCHED __builtin_amdgcn_sched_barrier(0)
    Unit cur, nxt; int ui = 0;
    if (!S.next(0, cur)) return;
    f32x4 acc[2][2][4][2];
#pragma unroll
    for (int a = 0; a < 2; ++a)
#pragma unroll
        for (int b = 0; b < 2; ++b)
#pragma unroll
            for (int m = 0; m < 4; ++m)
#pragma unroll
                for (int n = 0; n < 2; ++n) acc[a][b][m][n] = (f32x4){0.f, 0.f, 0.f, 0.f};
    bf16x8 At[4][2], B0[2][2], B1[2][2];
    const char* cA = (const char*)g.A + (size_t)cur.pm * tstep + (size_t)cur.kt0 * (BK * 2); const char* cB = (const char*)g.Bt + (size_t)cur.pn * tstep + (size_t)cur.kt0 * (BK * 2);
    S.a_ready(cur);
    if constexpr (SP2) {
        PG8_STAGE(PG8_SB(0, 0), cB, voffB); PG8_STAGE(PG8_SB(0, 1), cB + hstep, voffB); PG8_STAGE(PG8_SA(0, 0), cA, voffA); PG8_STAGE(PG8_SA(0, 1), cA + hstep, voffA);
        if (wr == 1) PG8_BAR;
        PG8_WAIT_V(2); PG8_BAR;
        PG8_STAGE(PG8_SB(1, 0), cB + kstep, voffB); PG8_STAGE(PG8_SA(1, 0), cA + kstep, voffA); PG8_STAGE(PG8_SB(1, 1), cB + hstep + kstep, voffB);
        PG8_WAIT_V(6); PG8_BAR;
    } else {
        PG8_STAGE(PG8_SB(0, 0), cB, voffB); PG8_STAGE(PG8_SA(0, 0), cA, voffA); PG8_STAGE(PG8_SB(0, 1), cB + hstep, voffB); PG8_STAGE(PG8_SA(0, 1), cA + hstep, voffA);
        if (wr == 1) PG8_BAR;
        PG8_WAIT_V(4); PG8_BAR;
        PG8_STAGE(PG8_SB(1, 0), cB + kstep, voffB); PG8_STAGE(PG8_SA(1, 0), cA + kstep, voffA); PG8_STAGE(PG8_SB(1, 1), cB + hstep + kstep, voffB);
        PG8_WAIT_V(6); PG8_BAR;
    }
    for (;;) {
        const bool has_next = S.next(ui + 1, nxt);
        const char* nA = has_next ? (const char*)g.A + (size_t)nxt.pm * tstep + (size_t)nxt.kt0 * (BK * 2) : cA; const char* nB = has_next ? (const char*)g.Bt + (size_t)nxt.pn * tstep + (size_t)nxt.kt0 * (BK * 2) : cB;
        const int nt = cur.nkt;
        for (int t = 0; t < nt; t += 2) {
            const bool last = (t == nt - 2);
            const char* a1 = cA + (size_t)(t + 1) * kstep;
            const char* a2 = last ? nA : cA + (size_t)(t + 2) * kstep; const char* b2 = last ? nB : cB + (size_t)(t + 2) * kstep;
            const char* a3 = a2 + kstep; const char* b3 = b2 + kstep;
            if (last && has_next) S.a_ready(nxt);
            if constexpr (SP2) {
            PG8_LDB(B0, 0, 0); PG8_LDB(B1, 0, 1); PG8_SCHED; PG8_LDA(At, 0, 0); PG8_STAGE(PG8_SA(1, 1), a1 + hstep, voffA);
            PG8_WAIT_V(8); PG8_WAIT_L(0); PG8_BAR; PG8_MMA(0, 0, At, B0); PG8_MMA(0, 1, At, B1); PG8_BAR; PG8_SCHED;
            PG8_LDA(At, 0, 1); PG8_STAGE(PG8_SB(0, 0), b2, voffB); PG8_STAGE(PG8_SB(0, 1), b2 + hstep, voffB); PG8_STAGE(PG8_SA(0, 0), a2, voffA);
            PG8_WAIT_V(8); PG8_WAIT_L(0); PG8_BAR; PG8_MMA(1, 0, At, B0); PG8_MMA(1, 1, At, B1); PG8_BAR; PG8_SCHED;
            PG8_LDB(B0, 1, 0); PG8_LDB(B1, 1, 1); PG8_SCHED; PG8_LDA(At, 1, 0); PG8_STAGE(PG8_SA(0, 1), a2 + hstep, voffA);
            PG8_WAIT_V(8); PG8_WAIT_L(0); PG8_BAR; PG8_MMA(0, 0, At, B0); PG8_MMA(0, 1, At, B1); PG8_BAR; PG8_SCHED;
            PG8_LDA(At, 1, 1); PG8_STAGE(PG8_SB(1, 0), b3, voffB); PG8_STAGE(PG8_SB(1, 1), b3 + hstep, voffB); PG8_STAGE(PG8_SA(1, 0), a3, voffA);
            PG8_WAIT_V(8); PG8_WAIT_L(0); PG8_BAR; PG8_MMA(1, 0, At, B0); PG8_MMA(1, 1, At, B1); PG8_BAR; PG8_SCHED;
            } else {
            PG8_LDB(B0, 0, 0); PG8_SCHED; PG8_LDA(At, 0, 0); PG8_STAGE(PG8_SA(1, 1), a1 + hstep, voffA);
            PG8_WAIT_L(8); PG8_BAR; PG8_WAIT_L(0); PG8_MMA(0, 0, At, B0); PG8_BAR; PG8_SCHED;
            PG8_LDB(B1, 0, 1); PG8_STAGE(PG8_SB(0, 0), b2, voffB);
            PG8_BAR; PG8_WAIT_L(0); PG8_MMA(0, 1, At, B1); PG8_BAR;
            PG8_LDA(At, 0, 1); PG8_STAGE(PG8_SA(0, 0), a2, voffA);
            PG8_BAR; PG8_WAIT_L(0); PG8_MMA(1, 0, At, B0); PG8_BAR; PG8_SCHED;
            PG8_STAGE(PG8_SB(0, 1), b2 + hstep, voffB);
            PG8_WAIT_V(6); PG8_BAR; PG8_MMA(1, 1, At, B1); PG8_BAR;
            PG8_LDB(B0, 1, 0); PG8_SCHED; PG8_LDA(At, 1, 0); PG8_STAGE(PG8_SA(0, 1), a2 + hstep, voffA);
            PG8_WAIT_L(8); PG8_BAR; PG8_WAIT_L(0); PG8_MMA(0, 0, At, B0); PG8_BAR; PG8_SCHED;
            PG8_LDB(B1, 1, 1); PG8_STAGE(PG8_SB(1, 0), b3, voffB);
            PG8_BAR; PG8_WAIT_L(0); PG8_MMA(0, 1, At, B1); PG8_BAR;
            PG8_LDA(At, 1, 1); PG8_STAGE(PG8_SA(1, 0), a3, voffA);
            PG8_BAR; PG8_WAIT_L(0); PG8_MMA(1, 0, At, B0); PG8_BAR; PG8_SCHED;
            PG8_STAGE(PG8_SB(1, 1), b3 + hstep, voffB);
            PG8_WAIT_V(6); PG8_BAR; PG8_MMA(1, 1, At, B1); PG8_BAR;
            }
        }
        if constexpr (ALIGN_EPI) { if (wr == 0) PG8_BAR; }
        if (cur.mode == 1) {
            __attribute__((address_space(1))) f32x4* pp = (__attribute__((address_space(1))) f32x4*)part + tid;
#pragma unroll
            for (int a = 0; a < 2; ++a)
#pragma unroll
                for (int b = 0; b < 2; ++b)
#pragma unroll
                    for (int m = 0; m < 4; ++m)
#pragma unroll
                        for (int n = 0; n < 2; ++n) { *pp = acc[a][b][m][n]; pp += 512; asm volatile("" : "+v"(pp)); }
        } else
        if constexpr (!Epi::AFTER_DRAIN) { E(acc, cur, wr, wc, fr, fq); S.done(cur); }
        if (!has_next) break;
        if (nxt.mode == 2) {
            const __attribute__((address_space(1))) f32x4* pp = (const __attribute__((address_space(1))) f32x4*)part + tid;
#pragma unroll
            for (int a = 0; a < 2; ++a)
#pragma unroll
                for (int b = 0; b < 2; ++b)
#pragma unroll
                    for (int m = 0; m < 4; ++m)
#pragma unroll
                        for (int n = 0; n < 2; ++n) { acc[a][b][m][n] = *pp; pp += 512; asm volatile("" : "+v"(pp)); }
        } else {
#pragma unroll
        for (int a = 0; a < 2; ++a)
#pragma unroll
            for (int b = 0; b < 2; ++b)
#pragma unroll
                for (int m = 0; m < 4; ++m)
#pragma unroll
                    for (int n = 0; n < 2; ++n) acc[a][b][m][n] = (f32x4){0.f, 0.f, 0.f, 0.f};
        }
        cur = nxt; cA = nA; cB = nB; ++ui;
        if constexpr (ALIGN_EPI) { if (wr == 1) PG8_BAR; }
    }
    PG8_WAIT_V(0);
    if constexpr (!ALIGN_EPI) { if (wr == 0) PG8_BAR; }
    PG8_BAR;
    if constexpr (Epi::AFTER_DRAIN) { E.fused(acc, cur, wr, wc, fr, fq, lds, wid, lane); S.done(cur); }
#undef PG8_SA
#undef PG8_SB
#undef PG8_STAGE
#undef PG8_LDA
#undef PG8_LDB
#undef PG8_MMA
#undef PG8_WAIT_V
#undef PG8_WAIT_L
#undef PG8_BAR
#undef PG8_SCHED
}
}

constexpr int NWAVES = 8;
constexpr int NB = 16, SEQ = 2048, D = 1024, NH = 16, HD = 64, NIN = 9216, CVK = 31;
constexpr int M = NB * SEQ;
constexpr float LN_EPS = 1e-5f;
constexpr float DN_ALPHA = 1.189207115002721f;

constexpr size_t MiB = 1u << 20;
constexpr size_t WS_CTL = 0;
constexpr size_t WS_STATS = 1 * MiB;
constexpr size_t WS_WIN = 2 * MiB;
constexpr size_t WS_WSB = 20 * MiB, WS_WCV = 22 * MiB, WS_WOUT = 24 * MiB;
constexpr size_t WS_K = 32 * MiB, WS_V = 96 * MiB, WS_SZSB = 160 * MiB, WS_U = 224 * MiB, WS_SZCV = 288 * MiB, WS_SGSB = 352 * MiB, WS_SGCV = 416 * MiB, WS_PART = 480 * MiB, WS_END = 512 * MiB;
constexpr size_t WS_MERGED = WS_K;
constexpr size_t WS_P = WS_V;

constexpr int LDS_BYTES = 147456;
constexpr int BAR_LDS_OFF = 139264;
constexpr int CW_BAR = 4096;
constexpr size_t CTL_ZERO_BYTES = 65536;

#define GAS __attribute__((address_space(1)))
#define LAS __attribute__((address_space(3)))
typedef unsigned short bf16;
typedef unsigned v4u __attribute__((ext_vector_type(4)));
typedef float f32x4 __attribute__((ext_vector_type(4)));
#define LDS_WAIT() asm volatile("s_waitcnt lgkmcnt(0)" ::: "memory")
__device__ __forceinline__ unsigned pk2(float lo, float hi) { return pg8::cvt_pk_bf16(lo, hi); }
__device__ __forceinline__ unsigned f2bf(float f) { return pk2(f, 0.f) & 0xffffu; }
__device__ __forceinline__ float bf2f(unsigned b) { return pg8::bflo(b); }

struct Frame {
    LAS unsigned char* lds;
    int tid, lane, wave, G, bid;
    const float *x, *ln_in_g, *ln_in_b, *w_in, *w_sb, *conv_w, *conv_b, *cln_g, *cln_b, *w_cv, *w_out, *lnp_g, *lnp_b;
    float* out; float* stats;
    bf16 *WIN, *WSB, *WCV, *WOUT, *XN, *ASB, *Q, *K, *V, *SZSB, *U, *SZCV, *SGSB, *SGCV, *MERGED, *P;
};

__device__ __forceinline__ float wave_sum(float v) {
#pragma unroll
    for (int o = 1; o < 64; o <<= 1) v += __shfl_xor(v, o);
    return v;
}
#define XB_TMO      128
#define XB_XCNT(j)  (256  + 64 * (j))
#define XB_XSUB(j)  (1280 + 64 * (j))
#define XB_XGEN(j)  (2304 + 64 * (j))
#define XB_TOP      3328
#define XB_TOPGEN   3392
#define XCD_BAR_WORDS 3456
#define XB_SPIN_CAP (1u << 18)

__device__ __forceinline__ unsigned xb_ld(unsigned* p)              { return __hip_atomic_load(p, __ATOMIC_RELAXED, __HIP_MEMORY_SCOPE_AGENT); }
__device__ __forceinline__ unsigned xb_add(unsigned* p, unsigned v) { return __hip_atomic_fetch_add(p, v, __ATOMIC_RELAXED, __HIP_MEMORY_SCOPE_AGENT); }
__device__ __forceinline__ unsigned xb_xcc_id() { return (unsigned)__builtin_amdgcn_s_getreg((3 << 11) | 20) & 0xFu; }
#define XB_SPIN(cond, bar) do { unsigned _sp = 0; while (cond) { __builtin_amdgcn_s_sleep(1); \
    if ((++_sp & 255u) == 0u) { if (xb_ld(&(bar)[XB_TMO])) break; if (_sp > XB_SPIN_CAP) { atomicAdd(&(bar)[XB_TMO], 1u); break; } } } } while (0)

struct XcdBarrier {
    unsigned* bar; unsigned x;
    volatile LAS unsigned* st;
};

__device__ __forceinline__ XcdBarrier xcd_barrier_post(unsigned* bar, volatile LAS unsigned* st) {
    XcdBarrier b; b.bar = bar; b.x = xb_xcc_id(); b.st = st;
    if (threadIdx.x == 0) (void)xb_add(&bar[XB_XCNT(b.x)], 1u);
    return b;
}
__device__ __forceinline__ void xcd_barrier_complete(unsigned* bar, unsigned x, unsigned& nloc, unsigned& nx) {
    const unsigned G = gridDim.x * gridDim.y * gridDim.z;
    unsigned sum, cnt, mine, sp = 0u;
    for (;;) {
        sum = 0u; cnt = 0u; mine = 0u;
#pragma unroll
        for (unsigned j = 0; j < 16; ++j) { const unsigned c = xb_ld(&bar[XB_XCNT(j)]); sum += c; cnt += (c > 0u) ? 1u : 0u; mine = (j == x) ? c : mine; }
        if (sum == G) break;
        __builtin_amdgcn_s_sleep(1);
        if ((++sp & 255u) == 0u) { if (xb_ld(&bar[XB_TMO])) break; if (sp > XB_SPIN_CAP) { atomicAdd(&bar[XB_TMO], 1u); break; } }
    }
    nloc = mine > 0u ? mine : 1u; nx = cnt > 0u ? cnt : 1u;
}

__device__ __forceinline__ void xcd_barrier(const XcdBarrier& b) {
    asm volatile("s_waitcnt vmcnt(0)" ::: "memory");
    __syncthreads();
    if (threadIdx.x == 0) {
        unsigned* bar = b.bar;
        __builtin_amdgcn_s_waitcnt(0);
        unsigned nloc = b.st[0], nx = b.st[1];
        if (nloc == 0u) { xcd_barrier_complete(bar, b.x, nloc, nx); b.st[0] = nloc; b.st[1] = nx; }
        const unsigned old = xb_add(&bar[XB_XSUB(b.x)], 1u);
        const unsigned gen = old / nloc;
        if (old + 1u == (gen + 1u) * nloc) {
            __builtin_amdgcn_fence(__ATOMIC_RELEASE, "agent");
            asm volatile("s_waitcnt vmcnt(0)" ::: "memory");
            const unsigned og = xb_add(&bar[XB_TOP], 1u);
            const unsigned tg = og / nx;
            if (og + 1u == (tg + 1u) * nx) xb_add(&bar[XB_TOPGEN], 1u);
            else XB_SPIN(xb_ld(&bar[XB_TOPGEN]) == tg, bar);
            __builtin_amdgcn_fence(__ATOMIC_ACQUIRE, "agent");
            xb_add(&bar[XB_XGEN(b.x)], 1u);
            asm volatile("s_waitcnt vmcnt(0)" ::: "memory");
        } else {
            XB_SPIN(xb_ld(&bar[XB_XGEN(b.x)]) == gen, bar);
            __builtin_amdgcn_fence(__ATOMIC_ACQUIRE, "agent");
            asm volatile("s_waitcnt vmcnt(0)" ::: "memory");
        }
    }
    __syncthreads();
}

__device__ __forceinline__ void p0_transpose_item(const float* W, int K, int N, bf16* WT, int dst_row0, int src_col0, int kb, LAS float* scr, int lane) {
    const int k0 = 64 * kb;
#pragma unroll 8
    for (int i = 0; i < 32; ++i) { const int kk = 2 * i + (lane >> 5); scr[kk * 33 + (lane & 31)] = W[(size_t)(k0 + kk) * N + src_col0 + (lane & 31)]; }
    LDS_WAIT(); asm volatile("" ::: "memory");
    const int c = lane & 7;
#pragma unroll
    for (int j = 0; j < 4; ++j) { const int n = (lane >> 3) + 8 * j; const LAS float* s = scr + (8 * c) * 33 + n;
        v4u o; o.x = pk2(s[0 * 33], s[1 * 33]); o.y = pk2(s[2 * 33], s[3 * 33]); o.z = pk2(s[4 * 33], s[5 * 33]); o.w = pk2(s[6 * 33], s[7 * 33]);
        *(GAS v4u*)(WT + (size_t)(dst_row0 + n) * K + k0 + 8 * c) = o; }
    LDS_WAIT(); asm volatile("" ::: "memory");
}
__device__ __forceinline__ int win_src_col(int n) {
    if (n < 4096 || n >= 6144) return n;
    const int r = n - 4096, j = r >> 8, q = r & 255;
    return q < 128 ? 4096 + 128 * j + q : 5120 + 128 * j + (q - 128);
}
__device__ __forceinline__ void p0_prologue(Frame& F) {
    LAS float* scr = (LAS float*)(F.lds + F.wave * 16384);
    const int gw = F.bid * NWAVES + F.wave, NGW = F.G * NWAVES;
    constexpr int I_IN = (D / 64) * (NIN / 32), I_SQ = (D / 64) * (D / 32);
    for (int it = gw; it < I_IN + 3 * I_SQ; it += NGW) {
        int r = it;
        if (r < I_IN) { const int kb = r / (NIN / 32), nb = r % (NIN / 32); p0_transpose_item(F.w_in, D, NIN, F.WIN, 32 * nb, win_src_col(32 * nb), kb, scr, F.lane); continue; } r -= I_IN;
        if (r < I_SQ) { p0_transpose_item(F.w_sb, D, D, F.WSB, 32 * (r % (D / 32)), 32 * (r % (D / 32)), r / (D / 32), scr, F.lane); continue; } r -= I_SQ;
        if (r < I_SQ) { p0_transpose_item(F.w_cv, D, D, F.WCV, 32 * (r % (D / 32)), 32 * (r % (D / 32)), r / (D / 32), scr, F.lane); continue; } r -= I_SQ;
        p0_transpose_item(F.w_out, D, D, F.WOUT, 32 * (r % (D / 32)), 32 * (r % (D / 32)), r / (D / 32), scr, F.lane);
    }
    for (int m = gw; m < M; m += NGW) {
        const GAS f32x4* xr = (const GAS f32x4*)(F.x + (size_t)m * D) + F.lane;
        f32x4 v[4]; float s = 0.f;
#pragma unroll
        for (int j = 0; j < 4; ++j) { v[j] = xr[64 * j]; s += (v[j].x + v[j].y) + (v[j].z + v[j].w); }
        const float mean = wave_sum(s) * (1.f / D); float s2 = 0.f;
#pragma unroll
        for (int j = 0; j < 4; ++j) { const f32x4 d = v[j] - mean; s2 += (d.x * d.x + d.y * d.y) + (d.z * d.z + d.w * d.w); }
        const float rstd = 1.f / sqrtf(wave_sum(s2) * (1.f / D) + LN_EPS);
        if (F.lane == 0) { F.stats[2 * m] = mean; F.stats[2 * m + 1] = rstd; }
        GAS unsigned long long* o8 = (GAS unsigned long long*)(F.XN + (size_t)m * D) + F.lane;
#pragma unroll
        for (int j = 0; j < 4; ++j) { const f32x4 g = *((const GAS f32x4*)F.ln_in_g + F.lane + 64 * j), b = *((const GAS f32x4*)F.ln_in_b + F.lane + 64 * j);
            const f32x4 y = ((v[j] - mean) * rstd) * g + b;
            o8[64 * j] = (unsigned long long)pk2(y.x, y.y) | ((unsigned long long)pk2(y.z, y.w) << 32); }
    }
}

__device__ __forceinline__ void attn_ref_task(Frame& F, int row, int h) {
    const int lane = F.lane; const int t = row & (SEQ - 1); const int rowb = row - t;
    float qd[64];
    { const GAS v4u* qp = (const GAS v4u*)(F.Q + (size_t)row * D + h * HD);
#pragma unroll
      for (int i = 0; i < 8; ++i) { const v4u w = qp[i]; qd[8 * i + 0] = bf2f(w.x & 0xffffu); qd[8 * i + 1] = bf2f(w.x >> 16); qd[8 * i + 2] = bf2f(w.y & 0xffffu); qd[8 * i + 3] = bf2f(w.y >> 16);
          qd[8 * i + 4] = bf2f(w.z & 0xffffu); qd[8 * i + 5] = bf2f(w.z >> 16); qd[8 * i + 6] = bf2f(w.w & 0xffffu); qd[8 * i + 7] = bf2f(w.w >> 16); } }
    float o = 0.f, carry = 0.f;
    for (int j = (t - 1) >> 6; j >= 0; --j) {
        const int s = 64 * j + lane;
        const GAS v4u* kp = (const GAS v4u*)(F.K + (size_t)(rowb + s) * D + h * HD);
        float xs = 0.f;
#pragma unroll
        for (int i = 0; i < 8; ++i) { const v4u w = kp[i];
            xs += qd[8 * i + 0] * bf2f(w.x & 0xffffu); xs += qd[8 * i + 1] * bf2f(w.x >> 16); xs += qd[8 * i + 2] * bf2f(w.y & 0xffffu); xs += qd[8 * i + 3] * bf2f(w.y >> 16);
            xs += qd[8 * i + 4] * bf2f(w.z & 0xffffu); xs += qd[8 * i + 5] * bf2f(w.z >> 16); xs += qd[8 * i + 6] * bf2f(w.w & 0xffffu); xs += qd[8 * i + 7] * bf2f(w.w >> 16); }
        const bool valid = s < t;
        const float sp = valid ? (fmaxf(xs, 0.f) + __builtin_amdgcn_logf(1.0f + __builtin_amdgcn_exp2f(-fabsf(xs)))) : 0.f;
        float suf = sp;
#pragma unroll
        for (int off = 1; off < 64; off <<= 1) { const float v = __shfl_down(suf, off); if (lane + off < 64) suf += v; }
        const float w = valid ? __builtin_amdgcn_exp2f(xs - (suf + carry)) : 0.f;
        carry += __shfl(suf, 0);
        const GAS bf16* vp = (const GAS bf16*)(F.V + (size_t)(rowb + 64 * j) * D + h * HD + lane);
        for (int i = 0; i < 64; ++i) { const float wi = __shfl(w, i); o += wi * bf2f(vp[(size_t)i * D]); }
    }
    const size_t oo = (size_t)row * D + h * HD + lane;
    const float sz = bf2f(F.SZSB[oo]);
    F.ASB[oo] = (bf16)f2bf(o * sz);
}
__device__ __forceinline__ void attn_ref_phase(Frame& F) {
    const int gw = F.bid * NWAVES + F.wave, NGW = F.G * NWAVES;
    for (int it = gw; it < M * NH; it += NGW) attn_ref_task(F, it >> 4, it & 15);
}

namespace sba {
using f32x16 = __attribute__((ext_vector_type(16))) float;
using bf16x8 = __attribute__((ext_vector_type(8))) short;
using s16x4 = __attribute__((ext_vector_type(4))) short;
typedef short v4i16_t __attribute__((ext_vector_type(4)));
constexpr int VDH = 4160;
constexpr int WBYTES = 8448;
constexpr float ATT_EXIT = 1.0e-9f;

__device__ __forceinline__ unsigned cvtpk(float lo, float hi) { return pg8::cvt_pk_bf16(lo, hi); }
#if USE_F16
__device__ __forceinline__ f32x16 mfma32(bf16x8 a, bf16x8 b, f32x16 c) { return __builtin_amdgcn_mfma_f32_32x32x16_f16(__builtin_bit_cast(pg8::h16x8, a), __builtin_bit_cast(pg8::h16x8, b), c, 0, 0, 0); }
#else
__device__ __forceinline__ f32x16 mfma32(bf16x8 a, bf16x8 b, f32x16 c) { return __builtin_amdgcn_mfma_f32_32x32x16_bf16(a, b, c, 0, 0, 0); }
#endif
__device__ __forceinline__ s16x4 vtr(LAS unsigned char* p) { return __builtin_bit_cast(s16x4, __builtin_amdgcn_ds_read_tr16_b64_v4i16((LAS v4i16_t*)p)); }

template <bool MASK>
__device__ __forceinline__ void tile_weights(const f32x16& p0, const f32x16& p1, float (&w)[32], float& carry, int kv0, int start, int r32, int hi) {
    float e[32], c[32], G[8];
    const int hiLim = r32 - kv0 - 4 * hi, loLim = -start - 4 * hi;
#pragma unroll
    for (int idx = 0; idx < 32; ++idx) { const int kvc = (idx >= 16 ? 32 : 0) + (idx & 3) + 8 * ((idx & 15) >> 2);
        float xv = fminf(idx < 16 ? p0[idx] : p1[idx - 16], 64.f);
        if (MASK) xv = (kvc < hiLim && kvc >= loLim) ? xv : -1000.f;
        e[idx] = __builtin_amdgcn_exp2f(xv); }
#pragma unroll
    for (int g = 0; g < 8; ++g) {
        float s = 1.f;
#pragma unroll
        for (int k = 3; k >= 0; --k) { const int idx = 4 * g + k; const float r = __builtin_amdgcn_rcpf(1.0f + e[idx]); s = (k == 3) ? r : s * r; c[idx] = s; }
        G[g] = s;
    }
    float run = carry;
#pragma unroll
    for (int g = 7; g >= 0; --g) {
        const auto rr = __builtin_amdgcn_permlane32_swap(__float_as_uint(G[g]), __float_as_uint(G[g]), false, false);
        const float ev = __uint_as_float(rr[0]), od = __uint_as_float(rr[1]);
        const float tmp = run * od; const float off = hi ? run : tmp; run = tmp * ev;
#pragma unroll
        for (int k = 0; k < 4; ++k) { const int idx = 4 * g + k; w[idx] = e[idx] * (off * c[idx]); }
    }
    carry = run;
}

__device__ __forceinline__ void attn_task(Frame& F, int b, int h, int qblk, LAS unsigned char* vl) {
    const int lane = F.lane, r32 = lane & 31, hi = lane >> 5;
    const int tw = 32 * qblk; const size_t rowb = (size_t)b * SEQ;
    const bf16* Qw = F.Q + (rowb + tw) * D + h * HD;
    const bf16* Kh = F.K + rowb * D + h * HD + hi * 8; const bf16* Vh = F.V + rowb * D + h * HD + (lane & 7) * 8;
    bf16x8 qr[4];
#pragma unroll
    for (int d0 = 0; d0 < 4; ++d0) qr[d0] = *(const GAS bf16x8*)(Qw + (size_t)r32 * D + d0 * 16 + hi * 8);
    f32x16 o[2]; o[0] = f32x16{}; o[1] = f32x16{};
    float carry = 1.f;
    LAS unsigned char* vwr = vl + ((lane & 7) >> 2) * VDH + (lane >> 3) * 64 + (lane & 3) * 16;
    LAS unsigned char* vrd = vl + ((lane >> 4) & 1) * 32 + (lane & 3) * 8 + (4 * hi + ((lane & 15) >> 2)) * 64;
    bf16x8 kf[2][4]; v4u vr[8];
#define SBA_LOAD(st) do { \
        _Pragma("unroll") for (int hh = 0; hh < 2; ++hh) { int kr = (st) + 32 * hh + r32; kr = kr < 0 ? 0 : kr; \
            _Pragma("unroll") for (int d0 = 0; d0 < 4; ++d0) kf[hh][d0] = *(const GAS bf16x8*)(Kh + (size_t)kr * D + d0 * 16); } \
        _Pragma("unroll") for (int it = 0; it < 8; ++it) { int vrw = (st) + 8 * it + (lane >> 3); vrw = vrw < 0 ? 0 : vrw; vr[it] = *(const GAS v4u*)(Vh + (size_t)vrw * D); } } while (0)
    SBA_LOAD(tw - 32);
    for (int i = 0;; ++i) {
        const int start = tw - 32 - 64 * i;
        f32x16 p0 = f32x16{}, p1 = f32x16{};
#pragma unroll
        for (int d0 = 0; d0 < 4; ++d0) { p0 = mfma32(kf[0][d0], qr[d0], p0); p1 = mfma32(kf[1][d0], qr[d0], p1); }
#pragma unroll
        for (int it = 0; it < 8; ++it) *(LAS v4u*)(vwr + it * 512) = vr[it];
        SBA_LOAD(start - 64);
        float w[32];
        if (i == 0 || start < 0) tile_weights<true>(p0, p1, w, carry, start - tw, start, r32, hi);
        else tile_weights<false>(p0, p1, w, carry, start - tw, start, r32, hi);
        bf16x8 pa[4];
#pragma unroll
        for (int ks = 0; ks < 4; ++ks) { v4u t; t.x = cvtpk(w[8 * ks + 0], w[8 * ks + 1]); t.y = cvtpk(w[8 * ks + 2], w[8 * ks + 3]); t.z = cvtpk(w[8 * ks + 4], w[8 * ks + 5]); t.w = cvtpk(w[8 * ks + 6], w[8 * ks + 7]); pa[ks] = __builtin_bit_cast(bf16x8, t); }
#pragma unroll
        for (int d0 = 0; d0 < 2; ++d0)
#pragma unroll
            for (int ks = 0; ks < 4; ++ks) { const s16x4 lo = vtr(vrd + d0 * VDH + ks * 1024), hi4 = vtr(vrd + d0 * VDH + ks * 1024 + 512);
                const bf16x8 vf = (bf16x8){lo[0], lo[1], lo[2], lo[3], hi4[0], hi4[1], hi4[2], hi4[3]};
                o[d0] = mfma32(pa[ks], vf, o[d0]); }
        if (start - 64 <= -64 || __all(carry < ATT_EXIT)) break;
    }
#undef SBA_LOAD
    LAS float* stg = (LAS float*)vl;
#pragma unroll
    for (int r = 0; r < 16; ++r) { const int q = (r & 3) + 8 * (r >> 2) + 4 * hi;
#pragma unroll
        for (int d0 = 0; d0 < 2; ++d0) stg[q * 64 + d0 * 32 + r32] = o[d0][r]; }
    const bf16* Zw = F.SZSB + (rowb + tw) * D + h * HD; bf16* Ow = F.ASB + (rowb + tw) * D + h * HD;
#pragma unroll
    for (int it = 0; it < 4; ++it) { const int row = it * 8 + (lane >> 3), ch = lane & 7;
        const f32x4 a0 = *(const LAS f32x4*)(stg + row * 64 + ch * 8), a1 = *(const LAS f32x4*)(stg + row * 64 + ch * 8 + 4);
        pg8::f32x4 z0, z1; pg8::unpack8(*(const GAS pg8::u32x4*)(Zw + (size_t)row * D + ch * 8), z0, z1);
        *(GAS pg8::u32x4*)(Ow + (size_t)row * D + ch * 8) = pg8::pack8(a0 * z0, a1 * z1); }
}
__device__ __forceinline__ void attn_phase(Frame& F) {
    LAS unsigned char* vl = F.lds + F.wave * WBYTES;
    for (int it = 0;; ++it) {
        const int tsk = (it * F.G + F.bid) * NWAVES + F.wave;
        if (tsk >= NB * NH * (SEQ / 32)) break;
        const int bh = tsk >> 6, qblk = tsk & 63;
        attn_task(F, bh >> 4, bh & 15, qblk, vl);
    }
}
}

typedef float f32x2 __attribute__((ext_vector_type(2)));
__device__ __forceinline__ float dppf(float v, const int ctrl_unused) { return v; }
#define DPP_ADD(v, ctrl) ((v) + __builtin_bit_cast(float, __builtin_amdgcn_update_dpp(0, __builtin_bit_cast(int, (v)), (ctrl), 0xF, 0xF, true)))
__device__ __forceinline__ float row_allsum(float v) {
    v = DPP_ADD(v, 0xB1); v = DPP_ADD(v, 0x4E); v = DPP_ADD(v, 0x124); v = DPP_ADD(v, 0x128); return v;
}
__device__ __forceinline__ void conv_phase(Frame& F, const int dry = 0) {
    const int tid = F.tid, c = 2 * tid, lane = F.lane;
    f32x2 wv[CVK];
#pragma unroll
    for (int k = 0; k < CVK; ++k) wv[k] = *(const GAS f32x2*)(F.conv_w + k * D + c);
    const f32x2 cb = *(const GAS f32x2*)(F.conv_b + c), lg = *(const GAS f32x2*)(F.cln_g + c), lb = *(const GAS f32x2*)(F.cln_b + c);
    LAS float* red = (LAS float*)(F.lds + 69632);
    const int li = lane & 15, R = lane >> 4;
    for (int tile = F.bid; tile < M / 128; tile += F.G) {
        const int t0 = tile * 128;
        const GAS unsigned* Up = (const GAS unsigned*)(F.U + (size_t)t0 * D + c);
        GAS unsigned* Zp = (GAS unsigned*)(F.SZCV + (size_t)t0 * D + c);
        f32x2 ring[32];
        const bool has_hist = (t0 & (SEQ - 1)) != 0;
#pragma unroll
        for (int r = 2; r < 32; ++r) { unsigned w = 0u; if (has_hist) w = Up[(r - 32) * (D / 2)]; ring[r] = (f32x2){bf2f(w & 0xffffu), bf2f(w >> 16)}; }
        ring[0] = (f32x2){0.f, 0.f}; ring[1] = (f32x2){0.f, 0.f};
        unsigned pre[8], zpre[8];
#pragma unroll
        for (int e = 0; e < 8; ++e) { pre[e] = Up[e * (D / 2)]; zpre[e] = Zp[e * (D / 2)]; }
        for (int blk = 0; blk < 4; ++blk) {
#pragma unroll
            for (int g = 0; g < 4; ++g) {
                const int rb = 32 * blk + 8 * g;
                unsigned cur[8], zc[8];
#pragma unroll
                for (int e = 0; e < 8; ++e) { cur[e] = pre[e]; zc[e] = zpre[e]; }
#pragma unroll
                for (int e = 0; e < 8; ++e) { pre[e] = Up[(rb + 8 + e) * (D / 2)]; zpre[e] = Zp[(rb + 8 + e) * (D / 2)]; }
                f32x2 y[8]; float st[16];
#pragma unroll
                for (int e = 0; e < 8; ++e) { const int j = 8 * g + e;
                    ring[j] = (f32x2){bf2f(cur[e] & 0xffffu), bf2f(cur[e] >> 16)};
                    f32x2 a = cb;
#pragma unroll
                    for (int k = 0; k < CVK; ++k) a += wv[k] * ring[(j + 2 + k) & 31];
                    y[e] = a; st[2 * e] = a.x + a.y; st[2 * e + 1] = a.x * a.x + a.y * a.y; }
                float a8[8], b4[4];
#pragma unroll
                for (int i = 0; i < 8; ++i) { const auto rr = __builtin_amdgcn_permlane32_swap(__float_as_uint(st[i]), __float_as_uint(st[i + 8]), false, false); a8[i] = __uint_as_float(rr[0]) + __uint_as_float(rr[1]); }
#pragma unroll
                for (int i = 0; i < 4; ++i) { const auto rr = __builtin_amdgcn_permlane16_swap(__float_as_uint(a8[i]), __float_as_uint(a8[i + 4]), false, false); b4[i] = row_allsum(__uint_as_float(rr[0]) + __uint_as_float(rr[1])); }
                LAS float* rp = red + (g & 1) * 128;
                { const float val = li == 0 ? b4[0] : li == 1 ? b4[1] : li == 2 ? b4[2] : b4[3]; if (li < 4) rp[(4 * R + li) * 8 + F.wave] = val; }
                __syncthreads();
                float tot = 0.f;
                if (lane < 16) { const f32x4 p = *(const LAS f32x4*)(rp + lane * 8), q = *(const LAS f32x4*)(rp + lane * 8 + 4); tot = ((p.x + p.y) + (p.z + p.w)) + ((q.x + q.y) + (q.z + q.w)); }
#pragma unroll
                for (int e = 0; e < 8; ++e) {
                    const float s1 = __builtin_amdgcn_readlane(tot, 2 * e), s2 = __builtin_amdgcn_readlane(tot, 2 * e + 1);
                    const float mean = s1 * (1.f / D), var = fmaxf(s2 * (1.f / D) - mean * mean, 0.f);
                    const float rstd = 1.f / sqrtf(var + LN_EPS);
                    const f32x2 yn = ((y[e] - mean) * rstd) * lg + lb;
                    const unsigned res = pk2(yn.x * pg8::sigmoidf_(yn.x) * bf2f(zc[e] & 0xffffu), yn.y * pg8::sigmoidf_(yn.y) * bf2f(zc[e] >> 16));
                    if (!dry) Zp[(rb + e) * (D / 2)] = res; }
            }
        }
    }
}

__device__ __forceinline__ void lnpost_phase(Frame& F, const int dry = 0) {
    const int gw = F.bid * NWAVES + F.wave, NGW = F.G * NWAVES;
    for (int m = gw; m < M; m += NGW) {
        GAS f32x4* xr = (GAS f32x4*)(F.out + (size_t)m * D) + F.lane;
        f32x4 v[4]; float s = 0.f;
#pragma unroll
        for (int j = 0; j < 4; ++j) { v[j] = xr[64 * j]; s += (v[j].x + v[j].y) + (v[j].z + v[j].w); }
        const float mean = wave_sum(s) * (1.f / D); float s2 = 0.f;
#pragma unroll
        for (int j = 0; j < 4; ++j) { v[j] = v[j] - mean; s2 += (v[j].x * v[j].x + v[j].y * v[j].y) + (v[j].z * v[j].z + v[j].w * v[j].w); }
        const float rstd = 1.f / sqrtf(wave_sum(s2) * (1.f / D) + LN_EPS);
#pragma unroll
        for (int j = 0; j < 4; ++j) { const f32x4 g = *((const GAS f32x4*)F.lnp_g + F.lane + 64 * j), b = *((const GAS f32x4*)F.lnp_b + F.lane + 64 * j); const f32x4 res = (v[j] * rstd) * g + b; if (!dry) xr[64 * j] = res; }
    }
}

#ifndef P1_STAGGER
#define P1_STAGGER 0
#endif
#ifndef PROBE_DRY_ALL
#define PROBE_DRY_ALL 1
#endif
struct Args { const float* in[13]; float* out; unsigned char* ws; int ph_lo, ph_hi, fused, dry, li, pad; };
constexpr int NPHASE = 8;
__global__ void __launch_bounds__(NWAVES * 64, 2) fwd_kernel(Args args) {
    extern __shared__ __attribute__((aligned(16))) unsigned char lds[];
    Frame F;
    F.lds = (LAS unsigned char*)lds;
    F.tid = threadIdx.x; F.lane = F.tid & 63; F.wave = __builtin_amdgcn_readfirstlane(F.tid >> 6); F.G = gridDim.x; F.bid = blockIdx.x;
    unsigned char* ws = args.ws;
    F.x = args.in[0]; F.ln_in_g = args.in[1]; F.ln_in_b = args.in[2]; F.w_in = args.in[3]; F.w_sb = args.in[4]; F.conv_w = args.in[5]; F.conv_b = args.in[6];
    F.cln_g = args.in[7]; F.cln_b = args.in[8]; F.w_cv = args.in[9]; F.w_out = args.in[10]; F.lnp_g = args.in[11]; F.lnp_b = args.in[12];
    F.out = args.out; F.stats = (float*)(ws + WS_STATS);
    F.WIN = (bf16*)(ws + WS_WIN); F.WSB = (bf16*)(ws + WS_WSB); F.WCV = (bf16*)(ws + WS_WCV); F.WOUT = (bf16*)(ws + WS_WOUT);
    F.XN = (bf16*)args.out; F.ASB = (bf16*)args.out; F.Q = (bf16*)args.out + (size_t)M * D;
    F.K = (bf16*)(ws + WS_K); F.V = (bf16*)(ws + WS_V); F.SZSB = (bf16*)(ws + WS_SZSB); F.U = (bf16*)(ws + WS_U); F.SZCV = (bf16*)(ws + WS_SZCV);
    F.SGSB = (bf16*)(ws + WS_SGSB); F.SGCV = (bf16*)(ws + WS_SGCV); F.MERGED = (bf16*)(ws + WS_MERGED); F.P = (bf16*)(ws + WS_P);
    const int lo = args.ph_lo, hi = args.ph_hi; const bool fused = args.fused != 0;
    volatile LAS unsigned* bst = (volatile LAS unsigned*)(F.lds + BAR_LDS_OFF);
    if (F.tid < 2) bst[F.tid] = 0u;
    __syncthreads();
    XcdBarrier bar; bar.bar = (unsigned*)(ws + WS_CTL) + CW_BAR + args.li * XCD_BAR_WORDS; bar.x = 0; bar.st = nullptr;
    if (fused) bar = xcd_barrier_post((unsigned*)(ws + WS_CTL) + CW_BAR + args.li * XCD_BAR_WORDS, bst);
#define IN(k) (lo <= (k) && (k) < hi)
#if defined(USE_CG_SYNC)
#define SEAM(k) do { if (fused && IN(k) && IN((k) + 1)) { cg::this_grid().sync(); } } while (0)
#else
#define SEAM(k) do { if (fused && IN(k) && IN((k) + 1)) { xcd_barrier(bar); } } while (0)
#endif

    if (IN(0)) { p0_prologue(F); } SEAM(0);
    if (IN(1)) {
        pg8::Gemm g{F.XN, F.WIN, M, NIN, D}; pg8::StaggerOrder S; S.init2(M, NIN, F.G, F.bid, (P1_STAGGER && F.G == 256) ? (F.bid & 1) : 0);
        pg8::f32x4* part = (pg8::f32x4*)(ws + WS_PART) + (size_t)(F.bid >> 1) * (65536 / 4);
        pg8::EpiIn E{F.Q, F.K, F.V, F.SZSB, F.U, F.SZCV, F.SGSB, F.SGCV, (args.dry & 2) && (PROBE_DRY_ALL || ((F.bid >> 3) & 1))};
        pg8::gemm_phase<pg8::EpiIn, pg8::StaggerOrder, true, true>(F.lds, g, S, E, part);
    } SEAM(1);
    #if defined(ATTN_REF)
    if (IN(2)) { attn_ref_phase(F); }
    if (IN(3)) { conv_phase(F, args.dry & 8); } SEAM(3);
#else
    if (IN(2)) { sba::attn_phase(F); }
    if (IN(3)) { conv_phase(F, args.dry & 8); } SEAM(3);
#endif
    if (IN(4)) {
        pg8::Gemm g{F.ASB, F.WSB, M, D, D}; pg8::StaticOrder S; S.init(M, D, F.G, F.bid);
        pg8::EpiGate E{F.SGSB, F.P};
        pg8::gemm_phase<pg8::EpiGate, pg8::StaticOrder, true, true>(F.lds, g, S, E);
    } SEAM(4);
    if (IN(5)) {
        pg8::Gemm g{F.SZCV, F.WCV, M, D, D}; pg8::StaticOrder S; S.init(M, D, F.G, F.bid);
        pg8::EpiGateAdd E{F.SGCV, F.P, F.MERGED};
        pg8::gemm_phase<pg8::EpiGateAdd, pg8::StaticOrder, true, true>(F.lds, g, S, E);
    } SEAM(5);
    if (IN(6)) {
        pg8::Gemm g{F.MERGED, F.WOUT, M, D, D}; pg8::StaticOrder S; S.init(M, D, F.G, F.bid);
        pg8::EpiOut E{F.x, F.stats, F.ln_in_g, F.ln_in_b, F.out, DN_ALPHA};
        pg8::gemm_phase<pg8::EpiOut, pg8::StaticOrder, true, true>(F.lds, g, S, E);
    } SEAM(6);
    if (IN(7)) { lnpost_phase(F, args.dry & 128); }
#undef IN
#undef SEAM
}

#ifndef MK_N_LAUNCHES
#define MK_N_LAUNCHES 1
#endif
extern "C" void kernel_launch(void* const* d_in, const int* in_sizes, int n_in, void* d_out, int out_size, void* d_ws, size_t ws_size, hipStream_t stream) {
    static int grid = 0;
    if (grid == 0) {
        if (n_in != 13 || in_sizes[0] != M * D || out_size != M * D || ws_size < WS_END) { fprintf(stderr, "kernel_launch: unexpected shapes (n_in %d, in0 %d, out %d, ws %zu); nothing launched\n", n_in, n_in > 0 ? in_sizes[0] : -1, out_size, ws_size); grid = -1; return; }
        int dev = 0, cus = 0, per_cu = 0;
        if (hipGetDevice(&dev) != hipSuccess || hipDeviceGetAttribute(&cus, hipDeviceAttributeMultiprocessorCount, dev) != hipSuccess) { grid = -1; return; }
        if (hipFuncSetAttribute((const void*)fwd_kernel, hipFuncAttributeMaxDynamicSharedMemorySize, LDS_BYTES) != hipSuccess) { fprintf(stderr, "kernel_launch: hipFuncSetAttribute failed\n"); grid = -1; return; }
        if (hipOccupancyMaxActiveBlocksPerMultiprocessor(&per_cu, (const void*)fwd_kernel, NWAVES * 64, LDS_BYTES) != hipSuccess || per_cu < 1) { fprintf(stderr, "kernel_launch: occupancy query says %d blocks per CU\n", per_cu); (void)hipGetLastError(); grid = -1; return; }
        grid = cus * (per_cu < 1 ? 1 : 1);
    }
    if (grid < 0) return;
    if (hipMemsetAsync((char*)d_ws + WS_CTL, 0, CTL_ZERO_BYTES, stream) != hipSuccess) { fprintf(stderr, "kernel_launch: hipMemsetAsync failed\n"); return; }
    Args a{};
    for (int i = 0; i < 13; ++i) a.in[i] = (const float*)d_in[i];
    a.out = (float*)d_out; a.ws = (unsigned char*)d_ws;
#if defined(PROBE_SPLIT)
    for (int li = 0; li < 2; ++li) {
        a.ph_lo = li == 0 ? 0 : PROBE_SPLIT; a.ph_hi = li == 0 ? PROBE_SPLIT + 1 : NPHASE; a.fused = 1; a.li = li;
#if defined(PROBE_DRY)
        a.dry = li == 0 ? (1 << PROBE_SPLIT) : 0;
#endif
        void* kargs[] = {&a};
        hipError_t e = hipLaunchCooperativeKernel((const void*)fwd_kernel, dim3(grid), dim3(NWAVES * 64), kargs, LDS_BYTES, stream);
        if (e != hipSuccess) fprintf(stderr, "kernel_launch: cooperative launch failed: %s (grid %d)\n", hipGetErrorString(e), grid);
    }
#else
    if (MK_N_LAUNCHES == 1) {
        a.ph_lo = 0; a.ph_hi = NPHASE; a.fused = 1;
        void* kargs[] = {&a};
        hipError_t e = hipLaunchCooperativeKernel((const void*)fwd_kernel, dim3(grid), dim3(NWAVES * 64), kargs, LDS_BYTES, stream);
        if (e != hipSuccess) fprintf(stderr, "kernel_launch: cooperative launch failed: %s (grid %d)\n", hipGetErrorString(e), grid);
    } else {
        for (int ph = 0; ph < NPHASE; ++ph) {
            a.ph_lo = ph; a.ph_hi = ph + 1; a.fused = 0;
            hipLaunchKernelGGL(fwd_kernel, dim3(grid), dim3(NWAVES * 64), LDS_BYTES, stream, a);
        }
    }
#endif
}
```
